# Optimizing an MI355X kernel written in HIP

```python
import jax, jax.numpy as jnp
from jax import lax
import numpy as np


D_MODEL = 2048
BATCH = 1
SEQ = 16384
DEPTH = 2

HEAD_DIM = 128
N_MAIN_HEADS = 12
N_KV_HEADS = 4
GROUP = N_MAIN_HEADS // N_KV_HEADS
N_MEM_HEADS = 4
N_MEM_TOKENS = 256
IDX_HEADS = 16
IDX_DIM = 64
IDX_TOPK_MAX = 256
MOBA_BLOCK = 256
MOBA_TOPK_MAX = 3
D_FF = 5632
ROPE_THETA = 10000.0
RMS_EPS = 1e-6
Q_CHUNK_A = 128
Q_CHUNK_B = 64
N_A_LAYERS = DEPTH // 2
N_B_LAYERS = DEPTH - N_A_LAYERS

A_SIZES = (N_MAIN_HEADS * HEAD_DIM, N_KV_HEADS * HEAD_DIM, N_KV_HEADS * HEAD_DIM,
           IDX_HEADS * IDX_DIM, IDX_DIM, IDX_HEADS, N_MEM_HEADS * HEAD_DIM)
B_SIZES = (N_MAIN_HEADS * HEAD_DIM, N_MEM_HEADS * HEAD_DIM)
MIX_WIDTH = (N_MAIN_HEADS + N_MEM_HEADS) * HEAD_DIM

kernel_name = 'yoco_dsa_moba_macaron_memory'


def split_cols(t, sizes):
    idx = [int(c) for c in np.cumsum(sizes)[:-1]]
    return jnp.split(t, idx, axis=-1)


def rms_norm(x, g):
    xf = x.astype(jnp.float32)
    y = xf * lax.rsqrt(jnp.mean(xf * xf, axis=-1, keepdims=True) + RMS_EPS)
    return (y * g.astype(jnp.float32)).astype(x.dtype)


def rope_tables(positions, dim):
    inv = 1.0 / (ROPE_THETA ** (jnp.arange(0, dim, 2, dtype=jnp.float32) / dim))
    ang = positions.astype(jnp.float32)[..., None] * inv
    return jnp.cos(ang), jnp.sin(ang)


def apply_rope(t, cos, sin):
    t1, t2 = jnp.split(t.astype(jnp.float32), 2, axis=-1)
    c = cos[:, :, None, :]
    s = sin[:, :, None, :]
    return jnp.concatenate([t1 * c - t2 * s, t1 * s + t2 * c], axis=-1).astype(t.dtype)


def swiglu(h, w_gate_up, w_down):
    g, u = jnp.split(h @ w_gate_up, 2, axis=-1)
    return (jax.nn.silu(g) * u) @ w_down


def to_chunks(t, chunk):
    b, s = t.shape[:2]
    return jnp.moveaxis(t.reshape((b, s // chunk, chunk) + t.shape[2:]), 1, 0)


def dsa_attention(q, k, v, q_idx, k_idx, w_idx, topk):
    b, s = q.shape[:2]
    n_chunks = s // Q_CHUNK_A
    key_pos = jnp.arange(s)
    bidx = jnp.arange(b)[:, None, None]
    scale = HEAD_DIM ** -0.5

    def one_chunk(args):
        qc, qic, wc, c0 = args
        qpos = c0 + jnp.arange(Q_CHUNK_A)
        dots = jnp.einsum('bqhd,bsd->bqhs', qic, k_idx).astype(jnp.float32)
        iscore = jnp.einsum('bqh,bqhs->bqs', wc.astype(jnp.float32), jax.nn.relu(dots))
        causal = key_pos[None, :] <= qpos[:, None]
        iscore = jnp.where(causal[None], iscore, -jnp.inf)
        _, sel = lax.top_k(iscore, topk)
        valid = sel <= qpos[None, :, None]
        ks = k[bidx, sel]
        vs = v[bidx, sel]
        qg = qc.reshape(b, Q_CHUNK_A, N_KV_HEADS, GROUP, HEAD_DIM)
        logits = jnp.einsum('bqgrd,bqkgd->bqgrk', qg, ks).astype(jnp.float32) * scale
        logits = jnp.where(valid[:, :, None, None, :], logits, -jnp.inf)
        p = jax.nn.softmax(logits, axis=-1).astype(vs.dtype)
        o = jnp.einsum('bqgrk,bqkgd->bqgrd', p, vs)
        return o.reshape(b, Q_CHUNK_A, N_MAIN_HEADS * HEAD_DIM)

    starts = jnp.arange(n_chunks, dtype=jnp.int32) * Q_CHUNK_A
    out = lax.map(one_chunk, (to_chunks(q, Q_CHUNK_A), to_chunks(q_idx, Q_CHUNK_A),
                              to_chunks(w_idx, Q_CHUNK_A), starts))
    return jnp.moveaxis(out, 0, 1).reshape(b, s, N_MAIN_HEADS * HEAD_DIM)


def moba_attention(q, k_blocks, v_blocks, k_means, n_sel):
    b, s = q.shape[:2]
    nb = k_blocks.shape[2]
    n_chunks = s // Q_CHUNK_B
    scale = HEAD_DIM ** -0.5
    bidx = jnp.arange(b)[:, None, None, None]
    hidx = (jnp.arange(N_MAIN_HEADS) // GROUP)[None, None, :, None]
    block_ids = jnp.arange(nb)

    def one_chunk(args):
        qc, c0 = args
        qpos = c0 + jnp.arange(Q_CHUNK_B)
        cur = c0 // MOBA_BLOCK
        qg = qc.reshape(b, Q_CHUNK_B, N_KV_HEADS, GROUP, HEAD_DIM)
        gate = jnp.einsum('bqgrd,bgnd->bqgrn', qg, k_means).astype(jnp.float32)
        gate = gate.reshape(b, Q_CHUNK_B, N_MAIN_HEADS, nb)
        gate = jnp.where(block_ids < cur, gate, -jnp.inf)
        _, sel = lax.top_k(gate, n_sel)
        sel_valid = sel < cur
        ks = k_blocks[bidx, hidx, sel]
        vs = v_blocks[bidx, hidx, sel]
        lp = jnp.einsum('bqhd,bqhnkd->bqhnk', qc, ks).astype(jnp.float32) * scale
        lp = jnp.where(sel_valid[..., None], lp, -jnp.inf)
        lp = lp.reshape(b, Q_CHUNK_B, N_MAIN_HEADS, n_sel * MOBA_BLOCK)
        k_own = lax.dynamic_index_in_dim(k_blocks, cur, axis=2, keepdims=False)
        v_own = lax.dynamic_index_in_dim(v_blocks, cur, axis=2, keepdims=False)
        own_pos = cur * MOBA_BLOCK + jnp.arange(MOBA_BLOCK)
        lo = jnp.einsum('bqgrd,bgkd->bqgrk', qg, k_own).astype(jnp.float32) * scale
        lo = lo.reshape(b, Q_CHUNK_B, N_MAIN_HEADS, MOBA_BLOCK)
        lo = jnp.where((own_pos[None, :] <= qpos[:, None])[None, :, None, :], lo, -jnp.inf)
        p = jax.nn.softmax(jnp.concatenate([lp, lo], axis=-1), axis=-1).astype(vs.dtype)
        p_sel = p[..., :n_sel * MOBA_BLOCK].reshape(b, Q_CHUNK_B, N_MAIN_HEADS, n_sel, MOBA_BLOCK)
        p_own = p[..., n_sel * MOBA_BLOCK:].reshape(b, Q_CHUNK_B, N_KV_HEADS, GROUP, MOBA_BLOCK)
        o = (jnp.einsum('bqhnk,bqhnkd->bqhd', p_sel, vs)
             + jnp.einsum('bqgrk,bgkd->bqgrd', p_own, v_own).reshape(b, Q_CHUNK_B, N_MAIN_HEADS, HEAD_DIM))
        return o.reshape(b, Q_CHUNK_B, N_MAIN_HEADS * HEAD_DIM)

    starts = jnp.arange(n_chunks, dtype=jnp.int32) * Q_CHUNK_B
    out = lax.map(one_chunk, (to_chunks(q, Q_CHUNK_B), starts))
    return jnp.moveaxis(out, 0, 1).reshape(b, s, N_MAIN_HEADS * HEAD_DIM)


def memory_attention(q_mem, mem_kv):
    b, s = q_mem.shape[:2]
    m = mem_kv.shape[1]
    qm = q_mem.reshape(b, s, N_MEM_HEADS, HEAD_DIM)
    km, vm = jnp.split(mem_kv, 2, axis=-1)
    km = km.reshape(b, m, N_MEM_HEADS, HEAD_DIM)
    vm = vm.reshape(b, m, N_MEM_HEADS, HEAD_DIM)
    logits = jnp.einsum('bshd,bmhd->bhsm', qm, km).astype(jnp.float32) * (HEAD_DIM ** -0.5)
    p = jax.nn.softmax(logits, axis=-1).astype(vm.dtype)
    return jnp.einsum('bhsm,bmhd->bshd', p, vm).reshape(b, s, N_MEM_HEADS * HEAD_DIM)


def setup_inputs(seed: int = 0) -> dict:
    key = jax.random.key(seed)
    ks = jax.random.split(key, 24)

    def w(k, shape, fan_in):
        return jax.random.normal(k, shape, jnp.float32) * (fan_in ** -0.5)

    def gain(k, shape):
        return 1.0 + 0.02 * jax.random.normal(k, shape, jnp.float32)

    a_in = sum(A_SIZES)
    b_in = sum(B_SIZES)
    kv_w = 2 * N_KV_HEADS * HEAD_DIM
    mem_w = 2 * N_MEM_HEADS * HEAD_DIM
    return {
        'x': jax.random.normal(ks[0], (BATCH, SEQ, D_MODEL), jnp.float32),
        'mem': jax.random.normal(ks[1], (BATCH, N_MEM_TOKENS, D_MODEL), jnp.float32),
        'positions': jnp.broadcast_to(jnp.arange(SEQ, dtype=jnp.int32), (BATCH, SEQ)),
        'ffn1_norm': gain(ks[2], (DEPTH, D_MODEL)),
        'ffn1_w_gate_up': w(ks[3], (DEPTH, D_MODEL, 2 * D_FF), D_MODEL),
        'ffn1_w_down': w(ks[4], (DEPTH, D_FF, D_MODEL), D_FF),
        'attn_norm': gain(ks[5], (DEPTH, D_MODEL)),
        'mem_norm': gain(ks[6], (DEPTH, D_MODEL)),
        'a_w_in': w(ks[7], (N_A_LAYERS, D_MODEL, a_in), D_MODEL),
        'idx_k_norm': gain(ks[8], (N_A_LAYERS, IDX_DIM)),
        'b_w_in': w(ks[9], (N_B_LAYERS, D_MODEL, b_in), D_MODEL),
        'w_mem_kv': w(ks[10], (DEPTH, D_MODEL, mem_w), D_MODEL),
        'w_out': w(ks[11], (DEPTH, MIX_WIDTH, D_MODEL), MIX_WIDTH),
        'ffn2_norm': gain(ks[12], (DEPTH, D_MODEL)),
        'ffn2_w_gate_up': w(ks[13], (DEPTH, D_MODEL, 2 * D_FF), D_MODEL),
        'ffn2_w_down': w(ks[14], (DEPTH, D_FF, D_MODEL), D_FF),
        'kv_norm': gain(ks[15], (D_MODEL,)),
        'w_kv_shared': w(ks[16], (D_MODEL, kv_w), D_MODEL),
        'final_norm': gain(ks[17], (D_MODEL,)),
    }


def reference(x, mem, positions, ffn1_norm, ffn1_w_gate_up, ffn1_w_down, attn_norm, mem_norm,
              a_w_in, idx_k_norm, b_w_in, w_mem_kv, w_out, ffn2_norm, ffn2_w_gate_up, ffn2_w_down,
              kv_norm, w_kv_shared, final_norm):
    b, s, _ = x.shape
    cos_h, sin_h = rope_tables(positions, HEAD_DIM)
    cos_i, sin_i = rope_tables(positions, IDX_DIM)
    topk = min(IDX_TOPK_MAX, s // 4)
    nb = -(-s // MOBA_BLOCK)
    n_sel = min(MOBA_TOPK_MAX, max(nb - 1, 1))
    idx_w_scale = (IDX_HEADS ** -0.5) * (IDX_DIM ** -0.5)

    k_blocks = v_blocks = k_means = None
    for i in range(DEPTH):
        if i == N_A_LAYERS:
            hk = rms_norm(x, kv_norm)
            k_sh, v_sh = jnp.split(hk @ w_kv_shared, 2, axis=-1)
            k_sh = apply_rope(k_sh.reshape(b, s, N_KV_HEADS, HEAD_DIM), cos_h, sin_h)
            v_sh = v_sh.reshape(b, s, N_KV_HEADS, HEAD_DIM)
            pad = nb * MOBA_BLOCK - s
            k_sh = jnp.pad(k_sh, ((0, 0), (0, pad), (0, 0), (0, 0)))
            v_sh = jnp.pad(v_sh, ((0, 0), (0, pad), (0, 0), (0, 0)))
            k_blocks = jnp.transpose(k_sh.reshape(b, nb, MOBA_BLOCK, N_KV_HEADS, HEAD_DIM), (0, 3, 1, 2, 4))
            v_blocks = jnp.transpose(v_sh.reshape(b, nb, MOBA_BLOCK, N_KV_HEADS, HEAD_DIM), (0, 3, 1, 2, 4))
            k_means = jnp.mean(k_blocks.astype(jnp.float32), axis=3).astype(k_blocks.dtype)

        x = x + 0.5 * swiglu(rms_norm(x, ffn1_norm[i]), ffn1_w_gate_up[i], ffn1_w_down[i])

        h = rms_norm(x, attn_norm[i])
        mem_kv = rms_norm(mem, mem_norm[i]) @ w_mem_kv[i]
        if i < N_A_LAYERS:
            q, k, v, qi, ki, wi, qm = split_cols(h @ a_w_in[i], A_SIZES)
            q = apply_rope(q.reshape(b, s, N_MAIN_HEADS, HEAD_DIM), cos_h, sin_h)
            k = apply_rope(k.reshape(b, s, N_KV_HEADS, HEAD_DIM), cos_h, sin_h)
            v = v.reshape(b, s, N_KV_HEADS, HEAD_DIM)
            qi = apply_rope(qi.reshape(b, s, IDX_HEADS, IDX_DIM), cos_i, sin_i)
            ki = apply_rope(rms_norm(ki, idx_k_norm[i])[:, :, None, :], cos_i, sin_i)[:, :, 0, :]
            wi = wi * idx_w_scale
            o_main = dsa_attention(q, k, v, qi, ki, wi, topk)
        else:
            j = i - N_A_LAYERS
            q, qm = split_cols(h @ b_w_in[j], B_SIZES)
            q = apply_rope(q.reshape(b, s, N_MAIN_HEADS, HEAD_DIM), cos_h, sin_h)
            o_main = moba_attention(q, k_blocks, v_blocks, k_means, n_sel)
        o_mem = memory_attention(qm, mem_kv)
        x = x + jnp.concatenate([o_main, o_mem], axis=-1) @ w_out[i]

        x = x + 0.5 * swiglu(rms_norm(x, ffn2_norm[i]), ffn2_w_gate_up[i], ffn2_w_down[i])

    return rms_norm(x, final_norm)
```

```cpp
#include <hip/hip_runtime.h>
#include <cstdio>
#include <cstdint>

#define LAS __attribute__((address_space(3)))
#define DI __device__ __forceinline__

constexpr int S = 16384, D = 2048, FF = 5632, NGU = 2 * FF;
constexpr int NH = 12, NKV = 4, NMH = 4, HD = 128, NMEM = 256, IH = 16, ID = 64, TOPK = 256, MBLK = 256, NBLK = S / MBLK;
constexpr int A_IN = 4176, NPA = 4352, B_IN = 2048, KVW = 1024;
constexpr float RMS_EPS = 1e-6f;
constexpr float ATT_SC = 0.08838834764831845f * 1.4426950408889634f;
constexpr float IDX_W_SCALE = 0.25f * 0.125f;
constexpr int NWAVES = 8, NTHREADS = 512;
constexpr int STAGE_LDS = 131072, MISC_LDS = 1024, LDS_BYTES = STAGE_LDS + MISC_LDS;

typedef unsigned short bf16_t;
typedef short bf16x8 __attribute__((ext_vector_type(8)));
typedef float f32x4 __attribute__((ext_vector_type(4)));
typedef float f32x2 __attribute__((ext_vector_type(2)));
typedef float f32x16 __attribute__((ext_vector_type(16)));
typedef unsigned u32x4 __attribute__((ext_vector_type(4)));
typedef unsigned u32x2 __attribute__((ext_vector_type(2)));
typedef __bf16 bf16v2_t __attribute__((ext_vector_type(2)));

DI unsigned pk_bf16(float a, float b) { f32x2 f = {a, b}; bf16v2_t r = __builtin_convertvector(f, bf16v2_t); return __builtin_bit_cast(unsigned, r); }
DI float bf_lo(unsigned u) { return __uint_as_float(u << 16); }
DI float bf_hi(unsigned u) { return __uint_as_float(u & 0xffff0000u); }
DI float shx(float v, int k, int lane) { return __int_as_float(__builtin_amdgcn_ds_bpermute((lane ^ k) << 2, __float_as_int(v))); }
DI unsigned shxu(unsigned v, int k, int lane) { return (unsigned)__builtin_amdgcn_ds_bpermute((lane ^ k) << 2, (int)v); }
DI float wave_sum(float v, int lane) { v += shx(v, 32, lane); v += shx(v, 16, lane); v += shx(v, 8, lane); v += shx(v, 4, lane); v += shx(v, 2, lane); v += shx(v, 1, lane); return v; }
DI void lds_fence() { asm volatile("s_waitcnt lgkmcnt(0)" ::: "memory"); }
DI int rope128_src(int p) { return ((p >> 2) & 1) * 64 + 4 * (p >> 3) + (p & 3); }
DI int rope64_src(int p) { return ((p >> 2) & 1) * 32 + 4 * (p >> 3) + (p & 3); }
DI int vt_pos(int key) { return (key & ~12) | ((key & 8) >> 1) | ((key & 4) << 1); }

constexpr size_t AL(size_t x) { return (x + 255) & ~(size_t)255; }
constexpr size_t WS_CTL = 0, CTL_BYTES = 65536;
constexpr size_t WS_ROPE = WS_CTL + CTL_BYTES;
constexpr size_t WS_WGU0 = WS_ROPE + (size_t)S * 64 * 4 * 2;
constexpr size_t WS_WDN0 = WS_WGU0 + (size_t)NGU * D * 2;
constexpr size_t WS_WGU1 = WS_WDN0 + (size_t)D * FF * 2;
constexpr size_t WS_WDN1 = WS_WGU1 + (size_t)NGU * D * 2;
constexpr size_t WS_WIN = WS_WDN1 + (size_t)D * FF * 2;
constexpr size_t WS_WOUT = WS_WIN + (size_t)NPA * D * 2;
constexpr size_t WS_WKV = WS_WOUT + (size_t)D * D * 2;
constexpr size_t WS_H = WS_WKV + (size_t)KVW * D * 2;
constexpr size_t WS_ACT = WS_H + (size_t)S * D * 2;
constexpr size_t WS_AO = WS_ACT + (size_t)S * FF * 2;
constexpr size_t WS_Q = WS_AO + (size_t)S * D * 2;
constexpr size_t WS_K = WS_Q + (size_t)S * NH * HD * 2;
constexpr size_t WS_V = WS_K + (size_t)S * NKV * HD * 2;
constexpr size_t WS_QI = WS_V + (size_t)S * NKV * HD * 2;
constexpr size_t WS_KI = WS_QI + (size_t)S * IH * ID * 2;
constexpr size_t WS_WI = WS_KI + (size_t)S * ID * 2;
constexpr size_t WS_QM = WS_WI + (size_t)S * IH * 4;
constexpr size_t WS_SEL = WS_QM + (size_t)S * NMH * HD * 2;
constexpr size_t WS_NSEL = WS_SEL + (size_t)S * TOPK * 2;
constexpr size_t WS_MEMK = WS_NSEL + (size_t)S * 4;
constexpr size_t WS_MEMVT = WS_MEMK + (size_t)2 * NMH * NMEM * HD * 2;
constexpr size_t WS_KMEAN = WS_MEMVT + (size_t)2 * NMH * NMEM * HD * 2;
constexpr size_t WS_ITEMS = WS_KMEAN + (size_t)NKV * NBLK * HD * 4;
constexpr int ITEM_CAP = 136, ITEM_U16 = 48, OWN_ITEMS = 24, SLOTS_PER_UNIT = ITEM_CAP + OWN_ITEMS;
constexpr size_t WS_NITEMS = WS_ITEMS + (size_t)256 * ITEM_CAP * ITEM_U16 * 2;
constexpr size_t WS_PML = WS_NITEMS + 1024;
constexpr size_t WS_END = WS_PML + (size_t)S * NH * 4 * 2 * 4;
constexpr size_t WS_PO = WS_H;
static_assert((size_t)S * NH * 4 * HD * 2 <= (WS_AO - WS_H), "MoBA partials must fit in H+ACT");
static_assert(WS_END < (size_t)760 * 1024 * 1024, "workspace budget");
#define XB_TMO      128
#define XB_XCNT(j)  (256  + 64 * (j))
#define XB_XSUB(j)  (1280 + 64 * (j))
#define XB_XGEN(j)  (2304 + 64 * (j))
#define XB_TOP      3328
#define XB_TOPGEN   3392
#define XCD_BAR_WORDS 3456
#define XB_SPIN_CAP (1u << 18)

__device__ __forceinline__ unsigned xb_ld(unsigned* p)              { return __hip_atomic_load(p, __ATOMIC_RELAXED, __HIP_MEMORY_SCOPE_AGENT); }
__device__ __forceinline__ unsigned xb_add(unsigned* p, unsigned v) { return __hip_atomic_fetch_add(p, v, __ATOMIC_RELAXED, __HIP_MEMORY_SCOPE_AGENT); }
__device__ __forceinline__ unsigned xb_xcc_id() { return (unsigned)__builtin_amdgcn_s_getreg((3 << 11) | 20) & 0xFu; }
#define XB_SPIN(cond, bar) do { unsigned _sp = 0; while (cond) { __builtin_amdgcn_s_sleep(1); \
    if ((++_sp & 255u) == 0u) { if (xb_ld(&(bar)[XB_TMO])) break; if (_sp > XB_SPIN_CAP) { atomicAdd(&(bar)[XB_TMO], 1u); break; } } } } while (0)

struct XcdBarrier {
    unsigned* bar; unsigned x;
    volatile LAS unsigned* st;
};

__device__ __forceinline__ XcdBarrier xcd_barrier_post(unsigned* bar, volatile LAS unsigned* st) {
    XcdBarrier b; b.bar = bar; b.x = xb_xcc_id(); b.st = st;
    if (threadIdx.x == 0) (void)xb_add(&bar[XB_XCNT(b.x)], 1u);
    return b;
}
__device__ __forceinline__ void xcd_barrier_complete(unsigned* bar, unsigned x, unsigned& nloc, unsigned& nx) {
    const unsigned G = gridDim.x * gridDim.y * gridDim.z;
    unsigned sum, cnt, mine, sp = 0u;
    for (;;) {
        sum = 0u; cnt = 0u; mine = 0u;
#pragma unroll
        for (unsigned j = 0; j < 16; ++j) { const unsigned c = xb_ld(&bar[XB_XCNT(j)]); sum += c; cnt += (c > 0u) ? 1u : 0u; mine = (j == x) ? c : mine; }
        if (sum == G) break;
        __builtin_amdgcn_s_sleep(1);
        if ((++sp & 255u) == 0u) { if (xb_ld(&bar[XB_TMO])) break; if (sp > XB_SPIN_CAP) { atomicAdd(&bar[XB_TMO], 1u); break; } }
    }
    nloc = mine > 0u ? mine : 1u; nx = cnt > 0u ? cnt : 1u;
}

__device__ __forceinline__ void xcd_barrier(const XcdBarrier& b) {
    asm volatile("s_waitcnt vmcnt(0)" ::: "memory");
    __syncthreads();
    if (threadIdx.x == 0) {
        unsigned* bar = b.bar;
        __builtin_amdgcn_s_waitcnt(0);
        unsigned nloc = b.st[0], nx = b.st[1];
        if (nloc == 0u) { xcd_barrier_complete(bar, b.x, nloc, nx); b.st[0] = nloc; b.st[1] = nx; }
        const unsigned old = xb_add(&bar[XB_XSUB(b.x)], 1u);
        const unsigned gen = old / nloc;
        if (old + 1u == (gen + 1u) * nloc) {
            __builtin_amdgcn_fence(__ATOMIC_RELEASE, "agent");
            asm volatile("s_waitcnt vmcnt(0)" ::: "memory");
            const unsigned og = xb_add(&bar[XB_TOP], 1u);
            const unsigned tg = og / nx;
            if (og + 1u == (tg + 1u) * nx) xb_add(&bar[XB_TOPGEN], 1u);
            else XB_SPIN(xb_ld(&bar[XB_TOPGEN]) == tg, bar);
            __builtin_amdgcn_fence(__ATOMIC_ACQUIRE, "agent");
            xb_add(&bar[XB_XGEN(b.x)], 1u);
            asm volatile("s_waitcnt vmcnt(0)" ::: "memory");
        } else {
            XB_SPIN(xb_ld(&bar[XB_XGEN(b.x)]) == gen, bar);
            __builtin_amdgcn_fence(__ATOMIC_ACQUIRE, "agent");
            asm volatile("s_waitcnt vmcnt(0)" ::: "memory");
        }
    }
    __syncthreads();
}

namespace pg8 {
#define PG8_LAS __attribute__((address_space(3)))
typedef unsigned short bf16_t;
typedef short bf16x8 __attribute__((ext_vector_type(8)));
typedef float f32x4 __attribute__((ext_vector_type(4)));
typedef unsigned u32x4 __attribute__((ext_vector_type(4)));
constexpr int BM = 256, BK = 64, HALF = 128, HTB = HALF * BK * 2  , STAGE_BYTES = 8 * HTB, NXCD = 8, WGM = 8;

__host__ __device__ __forceinline__ int lds_byte(int r, int c) { const int st = (r >> 4) * 2 + (c >> 5), rr = r & 15, cc = c & 31, ob = rr * 64 + cc * 2; return st * 1024 + (ob ^ (((ob >> 9) & 1) << 5)); }
__host__ __device__ __forceinline__ void stage_rc(int b, int& R, int& C) { const int st = b / 1024, sb = b % 1024, swz = sb ^ (((sb >> 9) & 1) << 5); R = (st >> 1) * 16 + swz / 64; C = (st & 1) * 32 + (swz % 64) / 2; }
__host__ __device__ __forceinline__ int perm32(int rho) { const int n = rho >> 4, i = rho & 15; return 8 * (i >> 2) + 4 * n + (i & 3); }

struct Unit { int pm, pn; };
struct Gemm { const bf16_t* A; const bf16_t* Bt; int M, N, K; };

struct StaticOrder {
    int nM, nN, nwg, G, c;
    __host__ __device__ void init(int M, int N, int G_, int c_) { nM = M / BM; nN = N / BM; nwg = nM * nN; G = G_; c = c_; }
    __host__ __device__ bool next(int i, Unit& u) const {
        const long L = (long)i * G + c; if (L >= nwg) return false;
        int wgid = (int)L; { const int q = nwg / NXCD, r = nwg % NXCD, xcd = wgid % NXCD, off = wgid / NXCD; wgid = (xcd < r ? xcd * (q + 1) : r * (q + 1) + (xcd - r) * q) + off; }
        const int nig = WGM * nN, gid = wgid / nig, fm = gid * WGM, gsz = (nM - fm) < WGM ? (nM - fm) : WGM;
        u.pm = fm + ((wgid % nig) % gsz); u.pn = (wgid % nig) / gsz; return true;
    }
    __device__ __forceinline__ void a_ready(const Unit&) const {}
    __device__ __forceinline__ void done(const Unit&) const {}
};
__device__ __forceinline__ unsigned cvt_pk_bf16(float lo, float hi) { return pk_bf16(lo, hi); }

template <class Epi, class Sched, bool STAMP = false>
__device__ __forceinline__ void gemm_phase(PG8_LAS unsigned char* lds, const Gemm g, const Sched& S, const Epi& E, unsigned long long* stamps, int tid_in) {
    int tid_o = tid_in; asm volatile("" : "+v"(tid_o));
    const int tid = tid_o, wid = __builtin_amdgcn_readfirstlane(tid >> 6), lane = tid & 63, wr = wid >> 2, wc = wid & 3, fr = lane & 15, fq = lane >> 4;
    const int K = g.K, nt = K / BK;
    int ts_lo = 0, ts_hi = 0, nts = 0; const unsigned long long rt_entry = STAMP ? (unsigned long long)wall_clock64() : 0ull;
#define PG8_STAMP() do { if (STAMP && wid == 0 && nts < 64) { const unsigned long long _c = (unsigned long long)clock64(); \
        ts_lo = (lane == nts) ? (int)(unsigned)_c : ts_lo; ts_hi = (lane == nts) ? (int)(unsigned)(_c >> 32) : ts_hi; ++nts; } } while (0)
    PG8_STAMP();
    unsigned voffA[2], voffB[2];
#pragma unroll
    for (int i = 0; i < 2; ++i) { int R, C; stage_rc(tid * 16 + i * 8192, R, C); const int Rb = Epi::PERM ? ((R & ~31) + perm32(R & 31)) : R;
        voffA[i] = (unsigned)(R * K + C) * 2u; voffB[i] = (unsigned)(Rb * K + C) * 2u; }
    const size_t kstep = (size_t)(BK * 2);
    const size_t hstep = (size_t)HALF * K * 2;
    const size_t tstep = 2 * hstep;
    const unsigned ldsw = (unsigned)wid * 1024u;
    const int aoff = lds_byte(wr * 64 + fr, fq * 8), boff = lds_byte(wc * 32 + fr, fq * 8);
#define PG8_SA(b, h) (((b) * 2 + (h)) * HTB)
#define PG8_SB(b, h) ((4 + (b) * 2 + (h)) * HTB)
#define PG8_STAGE(bufoff, gbase, voff) do { _Pragma("unroll") for (int _i = 0; _i < 2; ++_i) \
        __builtin_amdgcn_global_load_lds((const unsigned*)((const char*)(gbase) + (voff)[_i]), (PG8_LAS unsigned*)(lds + (bufoff) + ldsw + _i * 8192), 16, 0, 0); } while (0)
#define PG8_LDA(dst, b, h) do { _Pragma("unroll") for (int m = 0; m < 4; ++m) _Pragma("unroll") for (int k = 0; k < 2; ++k) dst[m][k] = *(const PG8_LAS bf16x8*)(lds + PG8_SA(b, h) + aoff + m * 2048 + k * 1024); } while (0)
#define PG8_LDB(dst, b, h) do { _Pragma("unroll") for (int n = 0; n < 2; ++n) _Pragma("unroll") for (int k = 0; k < 2; ++k) dst[n][k] = *(const PG8_LAS bf16x8*)(lds + PG8_SB(b, h) + boff + n * 2048 + k * 1024); } while (0)
#define PG8_MMA(ai, bj, At, Bt) do { __builtin_amdgcn_s_setprio(1); _Pragma("unroll") for (int m = 0; m < 4; ++m) _Pragma("unroll") for (int n = 0; n < 2; ++n) _Pragma("unroll") for (int k = 0; k < 2; ++k) \
        acc[ai][bj][m][n] = __builtin_amdgcn_mfma_f32_16x16x32_bf16(Bt[n][k], At[m][k], acc[ai][bj][m][n], 0, 0, 0); __builtin_amdgcn_s_setprio(0); } while (0)
#define PG8_WAIT_V(n) asm volatile("s_waitcnt vmcnt(" #n ")" ::: "memory")
#define PG8_WAIT_L(n) asm volatile("s_waitcnt lgkmcnt(" #n ")" ::: "memory")
#define PG8_BAR __builtin_amdgcn_s_barrier()
#define PG8_SCHED __builtin_amdgcn_sched_barrier(0)
    Unit cur, nxt; int ui = 0;
    if (!S.next(0, cur)) return;
    f32x4 acc[2][2][4][2];
#pragma unroll
    for (int a = 0; a < 2; ++a)
#pragma unroll
        for (int b = 0; b < 2; ++b)
#pragma unroll
            for (int m = 0; m < 4; ++m)
#pragma unroll
                for (int n = 0; n < 2; ++n) acc[a][b][m][n] = (f32x4){0.f, 0.f, 0.f, 0.f};
    bf16x8 At[4][2], B0[2][2], B1[2][2];
    const char* cA = (const char*)g.A + (size_t)cur.pm * tstep; const char* cB = (const char*)g.Bt + (size_t)cur.pn * tstep;
    S.a_ready(cur);
    PG8_STAGE(PG8_SB(0, 0), cB, voffB); PG8_STAGE(PG8_SA(0, 0), cA, voffA); PG8_STAGE(PG8_SB(0, 1), cB + hstep, voffB); PG8_STAGE(PG8_SA(0, 1), cA + hstep, voffA);
    if (wr == 1) PG8_BAR;
    PG8_WAIT_V(4); PG8_BAR;
    PG8_STAGE(PG8_SB(1, 0), cB + kstep, voffB); PG8_STAGE(PG8_SA(1, 0), cA + kstep, voffA); PG8_STAGE(PG8_SB(1, 1), cB + hstep + kstep, voffB);
    PG8_WAIT_V(6); PG8_BAR;
    PG8_STAMP();
    for (;;) {
        const bool has_next = S.next(ui + 1, nxt);
        const char* nA = has_next ? (const char*)g.A + (size_t)nxt.pm * tstep : cA; const char* nB = has_next ? (const char*)g.Bt + (size_t)nxt.pn * tstep : cB;
        for (int t = 0; t < nt; t += 2) {
            const bool last = (t == nt - 2);
            const char* a1 = cA + (size_t)(t + 1) * kstep;
            const char* a2 = last ? nA : cA + (size_t)(t + 2) * kstep; const char* b2 = last ? nB : cB + (size_t)(t + 2) * kstep;
            const char* a3 = a2 + kstep; const char* b3 = b2 + kstep;
            if (last && has_next) S.a_ready(nxt);
            PG8_LDB(B0, 0, 0); PG8_SCHED; PG8_LDA(At, 0, 0); PG8_STAGE(PG8_SA(1, 1), a1 + hstep, voffA);
            PG8_WAIT_L(8); PG8_BAR; PG8_WAIT_L(0); PG8_MMA(0, 0, At, B0); PG8_BAR; PG8_SCHED;
            PG8_LDB(B1, 0, 1); PG8_STAGE(PG8_SB(0, 0), b2, voffB);
            PG8_BAR; PG8_WAIT_L(0); PG8_MMA(0, 1, At, B1); PG8_BAR;
            PG8_LDA(At, 0, 1); PG8_STAGE(PG8_SA(0, 0), a2, voffA);
            PG8_BAR; PG8_WAIT_L(0); PG8_MMA(1, 0, At, B0); PG8_BAR; PG8_SCHED;
            PG8_STAGE(PG8_SB(0, 1), b2 + hstep, voffB);
            PG8_WAIT_V(6); PG8_BAR; PG8_MMA(1, 1, At, B1); PG8_BAR;
            PG8_LDB(B0, 1, 0); PG8_SCHED; PG8_LDA(At, 1, 0); PG8_STAGE(PG8_SA(0, 1), a2 + hstep, voffA);
            PG8_WAIT_L(8); PG8_BAR; PG8_WAIT_L(0); PG8_MMA(0, 0, At, B0); PG8_BAR; PG8_SCHED;
            PG8_LDB(B1, 1, 1); PG8_STAGE(PG8_SB(1, 0), b3, voffB);
            PG8_BAR; PG8_WAIT_L(0); PG8_MMA(0, 1, At, B1); PG8_BAR;
            PG8_LDA(At, 1, 1); PG8_STAGE(PG8_SA(1, 0), a3, voffA);
            PG8_BAR; PG8_WAIT_L(0); PG8_MMA(1, 0, At, B0); PG8_BAR; PG8_SCHED;
            PG8_STAGE(PG8_SB(1, 1), b3 + hstep, voffB);
            PG8_WAIT_V(6); PG8_BAR; PG8_MMA(1, 1, At, B1); PG8_BAR;
        }
        PG8_STAMP();
        if constexpr (!Epi::AFTER_DRAIN) { E(acc, cur, wr, wc, fr, fq); S.done(cur); }
        PG8_STAMP();
        if (!has_next) break;
#pragma unroll
        for (int a = 0; a < 2; ++a)
#pragma unroll
            for (int b = 0; b < 2; ++b)
#pragma unroll
                for (int m = 0; m < 4; ++m)
#pragma unroll
                    for (int n = 0; n < 2; ++n) acc[a][b][m][n] = (f32x4){0.f, 0.f, 0.f, 0.f};
        cur = nxt; cA = nA; cB = nB; ++ui;
    }
    PG8_WAIT_V(0);
    if (wr == 0) PG8_BAR;
    PG8_BAR;
    if constexpr (Epi::AFTER_DRAIN) { E.fused(acc, cur, wr, wc, fr, fq, lds, wid, lane); S.done(cur); }
    PG8_STAMP();
    if (STAMP && wid == 0) { stamps[lane] = lane < nts ? (((unsigned long long)(unsigned)ts_hi << 32) | (unsigned)ts_lo) : 0ull;
        if (lane == 62) stamps[62] = rt_entry; if (lane == 63) stamps[63] = (unsigned long long)wall_clock64(); }
#undef PG8_STAMP
#undef PG8_SA
#undef PG8_SB
#undef PG8_STAGE
#undef PG8_LDA
#undef PG8_LDB
#undef PG8_MMA
#undef PG8_WAIT_V
#undef PG8_WAIT_L
#undef PG8_BAR
#undef PG8_SCHED
}
}
using pg8::Unit;
constexpr int BM = pg8::BM, HALF = pg8::HALF;

DI u32x4 pack8(const f32x4 a, const f32x4 b) { u32x4 w; w.x = pk_bf16(a[0], a[1]); w.y = pk_bf16(a[2], a[3]); w.z = pk_bf16(b[0], b[1]); w.w = pk_bf16(b[2], b[3]); return w; }
DI float silu_mul(float g, float u) { return g * __builtin_amdgcn_rcpf(1.0f + __builtin_amdgcn_exp2f(-1.4426950408889634f * g)) * u; }

struct EpiSwiglu {
    static constexpr bool PERM = true, AFTER_DRAIN = false;
    bf16_t* O;
    DI void operator()(const f32x4 (&acc)[2][2][4][2], const Unit& u, int wr, int wc, int fr, int fq) const {
        asm volatile("" : "+v"(fr), "+v"(fq));
        const int row0 = u.pm * BM + wr * 64 + fr, col0 = u.pn * HALF + wc * 32 + 8 * fq;
#pragma unroll
        for (int ai = 0; ai < 2; ++ai)
#pragma unroll
            for (int m = 0; m < 4; ++m) {
                bf16_t* rowp = O + (size_t)(row0 + ai * HALF + m * 16) * FF + col0;
                f32x4 a, b;
#pragma unroll
                for (int e = 0; e < 4; ++e) { a[e] = silu_mul(acc[ai][0][m][0][e], acc[ai][1][m][0][e]); b[e] = silu_mul(acc[ai][0][m][1][e], acc[ai][1][m][1][e]); }
                *(u32x4*)rowp = pack8(a, b);
            }
    }
};

struct EpiResid {
    static constexpr bool PERM = false, AFTER_DRAIN = false;
    const float* Xin; float* Xout; float scale;
    DI void operator()(const f32x4 (&acc)[2][2][4][2], const Unit& u, int wr, int wc, int fr, int fq) const {
        asm volatile("" : "+v"(fr), "+v"(fq));
        const int row0 = u.pm * BM + wr * 64 + fr, col0 = u.pn * BM + wc * 32 + 4 * fq;
#pragma unroll
        for (int ai = 0; ai < 2; ++ai)
#pragma unroll
            for (int m = 0; m < 4; ++m) {
                const size_t ro = (size_t)(row0 + ai * HALF + m * 16) * D + col0;
                f32x4 xv[2][2];
#pragma unroll
                for (int bj = 0; bj < 2; ++bj)
#pragma unroll
                    for (int n = 0; n < 2; ++n) xv[bj][n] = *(const f32x4*)(Xin + ro + bj * HALF + n * 16);
#pragma unroll
                for (int bj = 0; bj < 2; ++bj)
#pragma unroll
                    for (int n = 0; n < 2; ++n) *(f32x4*)(Xout + ro + bj * HALF + n * 16) = xv[bj][n] + scale * acc[ai][bj][m][n];
            }
    }
};

template <int MODE> struct EpiProj {
    static constexpr bool PERM = true, AFTER_DRAIN = false;
    bf16_t *Q, *K, *V, *QI, *KI, *QM; float* WI; const float* COS; const float* SIN; const float* kgain;
    DI void rope128_tile(const f32x4 (&acc)[2][2][4][2], bf16_t* dst, int heads_per_row, int head0, int row0, int wc, int fq) const {
        const int g = 4 * wc + fq;
#pragma unroll
        for (int ai = 0; ai < 2; ++ai)
#pragma unroll
            for (int m = 0; m < 4; ++m) {
                const int row = row0 + ai * HALF + m * 16;
                const f32x4 c = *(const f32x4*)(COS + (size_t)row * 64 + 4 * g), s = *(const f32x4*)(SIN + (size_t)row * 64 + 4 * g);
#pragma unroll
                for (int bj = 0; bj < 2; ++bj) {
                    const f32x4 x1 = acc[ai][bj][m][0], x2 = acc[ai][bj][m][1];
                    const f32x4 y1 = x1 * c - x2 * s, y2 = x1 * s + x2 * c;
                    *(u32x4*)(dst + ((size_t)row * heads_per_row + head0 + bj) * HD + 8 * g) = pack8(y1, y2);
                }
            }
    }
    DI void plain_tile(const f32x4 (&acc)[2][2][4][2], bf16_t* dst, int heads_per_row, int head0, int row0, int wc, int fq) const {
        const int p0 = wc * 32 + 8 * fq;
#pragma unroll
        for (int ai = 0; ai < 2; ++ai)
#pragma unroll
            for (int m = 0; m < 4; ++m) {
                const int row = row0 + ai * HALF + m * 16;
#pragma unroll
                for (int bj = 0; bj < 2; ++bj) *(u32x4*)(dst + ((size_t)row * heads_per_row + head0 + bj) * HD + p0) = pack8(acc[ai][bj][m][0], acc[ai][bj][m][1]);
            }
    }
    DI void operator()(const f32x4 (&acc)[2][2][4][2], const Unit& u, int wr, int wc, int fr, int fq) const {
        asm volatile("" : "+v"(fr), "+v"(fq));
        const int row0 = u.pm * BM + wr * 64 + fr, pn = u.pn;
        if (MODE == 1) { if (pn < 6) rope128_tile(acc, Q, NH, 2 * pn, row0, wc, fq); else plain_tile(acc, QM, NMH, 2 * (pn - 6), row0, wc, fq); return; }
        if (MODE == 2) { if (pn < 2) rope128_tile(acc, K, NKV, 2 * pn, row0, wc, fq); else plain_tile(acc, V, NKV, 2 * (pn - 2), row0, wc, fq); return; }
        if (pn < 6) { rope128_tile(acc, Q, NH, 2 * pn, row0, wc, fq); return; }
        if (pn < 8) { rope128_tile(acc, K, NKV, 2 * (pn - 6), row0, wc, fq); return; }
        if (pn < 10) { plain_tile(acc, V, NKV, 2 * (pn - 8), row0, wc, fq); return; }
        if (pn >= 14 && pn < 16) { plain_tile(acc, QM, NMH, 2 * (pn - 14), row0, wc, fq); return; }
        if (pn < 14) {
            const int hh = wc >> 1, gp = (4 * wc + fq) & 7;
#pragma unroll
            for (int ai = 0; ai < 2; ++ai)
#pragma unroll
                for (int m = 0; m < 4; ++m) {
                    const int row = row0 + ai * HALF + m * 16;
                    const f32x4 c0 = *(const f32x4*)(COS + (size_t)row * 64 + 8 * gp), c1 = *(const f32x4*)(COS + (size_t)row * 64 + 8 * gp + 4);
                    const f32x4 s0 = *(const f32x4*)(SIN + (size_t)row * 64 + 8 * gp), s1 = *(const f32x4*)(SIN + (size_t)row * 64 + 8 * gp + 4);
                    const f32x4 c = {c0[0], c0[2], c1[0], c1[2]}, s = {s0[0], s0[2], s1[0], s1[2]};
#pragma unroll
                    for (int bj = 0; bj < 2; ++bj) {
                        const int ih = ((pn - 10) * 2 + bj) * 2 + hh;
                        const f32x4 x1 = acc[ai][bj][m][0], x2 = acc[ai][bj][m][1];
                        const f32x4 y1 = x1 * c - x2 * s, y2 = x1 * s + x2 * c;
                        *(u32x4*)(QI + ((size_t)row * IH + ih) * ID + 8 * gp) = pack8(y1, y2);
                    }
                }
            return;
        }
        if (wc == 0) {
#pragma unroll
            for (int ai = 0; ai < 2; ++ai)
#pragma unroll
                for (int m = 0; m < 4; ++m) {
                    const int row = row0 + ai * HALF + m * 16;
                    float ss = 0.f;
#pragma unroll
                    for (int bj = 0; bj < 2; ++bj)
#pragma unroll
                        for (int n = 0; n < 2; ++n) { const f32x4 x = acc[ai][bj][m][n]; ss += (x[0] * x[0] + x[1] * x[1]) + (x[2] * x[2] + x[3] * x[3]); }
                    { const int ln = fr + 16 * fq; ss += shx(ss, 16, ln); ss += shx(ss, 32, ln); }
                    const float rs = rsqrtf(ss * (1.0f / 64.0f) + RMS_EPS);
#pragma unroll
                    for (int n = 0; n < 2; ++n) {
                        const f32x4 ga = *(const f32x4*)(kgain + 8 * fq + 4 * n), gb = *(const f32x4*)(kgain + 32 + 8 * fq + 4 * n);
                        const f32x4 t0 = *(const f32x4*)(COS + (size_t)row * 64 + 16 * fq + 8 * n), t1 = *(const f32x4*)(COS + (size_t)row * 64 + 16 * fq + 8 * n + 4);
                        const f32x4 u0 = *(const f32x4*)(SIN + (size_t)row * 64 + 16 * fq + 8 * n), u1 = *(const f32x4*)(SIN + (size_t)row * 64 + 16 * fq + 8 * n + 4);
                        const f32x4 c = {t0[0], t0[2], t1[0], t1[2]}, s = {u0[0], u0[2], u1[0], u1[2]};
                        const f32x4 a = acc[ai][0][m][n] * rs * ga, b = acc[ai][1][m][n] * rs * gb;
                        const f32x4 y1 = a * c - b * s, y2 = a * s + b * c;
                        *(u32x4*)(KI + (size_t)row * ID + 16 * fq + 8 * n) = pack8(y1, y2);
                    }
                }
        } else if (wc == 1 && fq < 2) {
#pragma unroll
            for (int ai = 0; ai < 2; ++ai)
#pragma unroll
                for (int m = 0; m < 4; ++m) {
                    const int row = row0 + ai * HALF + m * 16;
#pragma unroll
                    for (int n = 0; n < 2; ++n) *(f32x4*)(WI + (size_t)row * IH + 8 * fq + 4 * n) = acc[ai][0][m][n] * IDX_W_SCALE;
                }
        }
    }
};

enum { CT_ID = 0, CT_GU = 1, CT_WINA = 2, CT_WINB = 3, CT_WKV = 4 };
DI int conv_srccol(int type, int np) {
    const int tile = np >> 8, bj = (np >> 7) & 1, p = np & 127;
    switch (type) {
    case CT_ID: return np;
    case CT_GU: return bj * FF + tile * 128 + p;
    case CT_WINA:
        if (tile < 6) return (2 * tile + bj) * HD + rope128_src(p);
        if (tile < 8) return 1536 + (2 * (tile - 6) + bj) * HD + rope128_src(p);
        if (tile < 10) return 2048 + (2 * (tile - 8) + bj) * HD + p;
        if (tile < 14) return 2560 + ((((tile - 10) * 2 + bj) * 2) + (p >> 6)) * ID + rope64_src(p & 63);
        if (tile < 16) return 3664 + (2 * (tile - 14) + bj) * HD + p;
        if (bj == 0) return p < 32 ? 3584 + p : (p < 48 ? 3648 + (p - 32) : -1);
        return p < 32 ? 3584 + 32 + p : -1;
    case CT_WINB:
        if (tile < 6) return (2 * tile + bj) * HD + rope128_src(p);
        return 1536 + (2 * (tile - 6) + bj) * HD + p;
    default:
        if (tile < 2) return (2 * tile + bj) * HD + rope128_src(p);
        return 512 + (2 * (tile - 2) + bj) * HD + p;
    }
}
DI void conv_task(const float* src, bf16_t* dst, int ld, int K, int NP, int type, LAS float* tile, int tid, int bid, int G) {
    const int nkt = K / 64, ntile = nkt * (NP / 64);
    for (int ti = bid; ti < ntile; ti += G) {
        const int n0 = (ti / nkt) * 64, k0 = (ti % nkt) * 64;
        const int nn = tid & 63, kk = tid >> 6;
        const int sc = conv_srccol(type, n0 + nn);
#pragma unroll
        for (int i = 0; i < 8; ++i) { const int k = k0 + kk + 8 * i; tile[(kk + 8 * i) * 65 + nn] = sc >= 0 ? src[(size_t)k * ld + sc] : 0.f; }
        __syncthreads();
        const int row = tid >> 3, ch = tid & 7;
        f32x4 a, b;
#pragma unroll
        for (int j = 0; j < 4; ++j) { a[j] = tile[(ch * 8 + j) * 65 + row]; b[j] = tile[(ch * 8 + 4 + j) * 65 + row]; }
        *(u32x4*)(dst + (size_t)(n0 + row) * K + k0 + ch * 8) = pack8(a, b);
        __syncthreads();
    }
}

DI void memkv_unit(int unit, const float* mem, const float* gain_all, const float* W_all, bf16_t* MEMK, bf16_t* MEMVT, LAS float* hn, int tid) {
    const int L = unit >> 5, m0 = (unit & 31) * 8, wave = tid >> 6, lane = tid & 63;
    {
        const f32x4* xp = (const f32x4*)(mem + (size_t)(m0 + wave) * D); const f32x4* gp = (const f32x4*)(gain_all + (size_t)L * D);
        f32x4 v[8]; float ss = 0.f;
#pragma unroll
        for (int i = 0; i < 8; ++i) { v[i] = xp[lane + 64 * i]; ss += (v[i][0] * v[i][0] + v[i][1] * v[i][1]) + (v[i][2] * v[i][2] + v[i][3] * v[i][3]); }
        ss = wave_sum(ss, lane); const float rs = rsqrtf(ss * (1.0f / D) + RMS_EPS);
#pragma unroll
        for (int i = 0; i < 8; ++i) { const f32x4 y = v[i] * rs * gp[lane + 64 * i]; *(LAS f32x4*)(hn + wave * D + 4 * (lane + 64 * i)) = y; }
    }
    __syncthreads();
    const float* W = W_all + (size_t)L * D * KVW;
    float a0[8], a1[8];
#pragma unroll
    for (int r = 0; r < 8; ++r) { a0[r] = 0.f; a1[r] = 0.f; }
#pragma unroll 4
    for (int k = 0; k < D; ++k) {
        const float w0 = W[(size_t)k * KVW + tid], w1 = W[(size_t)k * KVW + 512 + tid];
#pragma unroll
        for (int r = 0; r < 8; ++r) { const float h = hn[r * D + k]; a0[r] = fmaf(h, w0, a0[r]); a1[r] = fmaf(h, w1, a1[r]); }
    }
    const int hm = tid >> 7, d = tid & 127;
#pragma unroll
    for (int r = 0; r < 8; ++r) {
        const int m = m0 + r;
        MEMK[((size_t)(L * NMH + hm) * NMEM + m) * HD + d] = (bf16_t)(pk_bf16(a0[r], 0.f) & 0xffffu);
        MEMVT[((size_t)(L * NMH + hm) * HD + d) * NMEM + vt_pos(m)] = (bf16_t)(pk_bf16(a1[r], 0.f) & 0xffffu);
    }
    __syncthreads();
}

DI void norm_rows(const float* X, const float* g1, bf16_t* O1, const float* g2, bf16_t* O2, int gw, int W, int lane) {
    for (int row = gw; row < S; row += W) {
        const f32x4* xp = (const f32x4*)(X + (size_t)row * D);
        f32x4 v[8]; float ss = 0.f;
#pragma unroll
        for (int i = 0; i < 8; ++i) { v[i] = xp[lane + 64 * i]; ss += (v[i][0] * v[i][0] + v[i][1] * v[i][1]) + (v[i][2] * v[i][2] + v[i][3] * v[i][3]); }
        ss = wave_sum(ss, lane); const float rs = rsqrtf(ss * (1.0f / D) + RMS_EPS);
#pragma unroll
        for (int i = 0; i < 8; ++i) {
            const f32x4 y = v[i] * rs * ((const f32x4*)g1)[lane + 64 * i];
            u32x2 w; w.x = pk_bf16(y[0], y[1]); w.y = pk_bf16(y[2], y[3]);
            *(u32x2*)(O1 + (size_t)row * D + 4 * (lane + 64 * i)) = w;
        }
        if (g2) {
#pragma unroll
            for (int i = 0; i < 8; ++i) {
                const f32x4 y = v[i] * rs * ((const f32x4*)g2)[lane + 64 * i];
                u32x2 w; w.x = pk_bf16(y[0], y[1]); w.y = pk_bf16(y[2], y[3]);
                *(u32x2*)(O2 + (size_t)row * D + 4 * (lane + 64 * i)) = w;
            }
        }
    }
}
DI void final_norm_rows(float* X, const float* g, int gw, int W, int lane) {
    for (int row = gw; row < S; row += W) {
        f32x4* xp = (f32x4*)(X + (size_t)row * D);
        f32x4 v[8]; float ss = 0.f;
#pragma unroll
        for (int i = 0; i < 8; ++i) { v[i] = xp[lane + 64 * i]; ss += (v[i][0] * v[i][0] + v[i][1] * v[i][1]) + (v[i][2] * v[i][2] + v[i][3] * v[i][3]); }
        ss = wave_sum(ss, lane); const float rs = rsqrtf(ss * (1.0f / D) + RMS_EPS);
#pragma unroll
        for (int i = 0; i < 8; ++i) xp[lane + 64 * i] = v[i] * rs * ((const f32x4*)g)[lane + 64 * i];
    }
}

DI void kvpost_unit(int unit, const bf16_t* Kb, const bf16_t* Vb, float* KMEAN, bf16_t* VT, LAS unsigned char* lds, int tid) {
    const int g = unit & 3, n = unit >> 2;
    LAS unsigned short* lv = (LAS unsigned short*)lds;
    LAS float* part = (LAS float*)(lds + 65536);
#pragma unroll
    for (int i = 0; i < 8; ++i) {
        const int item = tid + 512 * i, key = item >> 4, c = item & 15;
        const u32x4 w = *(const u32x4*)(Vb + ((size_t)(n * MBLK + key) * NKV + g) * HD + 8 * c);
        *(LAS u32x4*)(lv + key * HD + 8 * c) = w;
    }
    {
        const int d = tid & 127, part_id = tid >> 7; float s = 0.f;
        for (int k = 0; k < 64; ++k) { const int key = part_id * 64 + k; s += bf_lo((unsigned)Kb[((size_t)(n * MBLK + key) * NKV + g) * HD + d]); }
        part[part_id * 128 + d] = s;
    }
    __syncthreads();
    if (tid < 128) KMEAN[(size_t)(g * NBLK + n) * HD + tid] = (part[tid] + part[128 + tid] + part[256 + tid] + part[384 + tid]) * (1.0f / MBLK);
#pragma unroll
    for (int i = 0; i < 8; ++i) {
        const int item = tid + 512 * i, d = item & 127, c = item >> 7;
        unsigned short e[8];
#pragma unroll
        for (int j = 0; j < 8; ++j) e[j] = lv[vt_pos(8 * c + j) * HD + d];
        u32x4 w; w.x = e[0] | ((unsigned)e[1] << 16); w.y = e[2] | ((unsigned)e[3] << 16); w.z = e[4] | ((unsigned)e[5] << 16); w.w = e[6] | ((unsigned)e[7] << 16);
        *(u32x4*)(VT + ((size_t)(g * NBLK + n) * HD + d) * MBLK + 8 * c) = w;
    }
    __syncthreads();
}
#define MFMA32(a, b, c) __builtin_amdgcn_mfma_f32_32x32x16_bf16((a), (b), (c), 0, 0, 0)
#define MFMA16(a, b, c) __builtin_amdgcn_mfma_f32_16x16x32_bf16((a), (b), (c), 0, 0, 0)
constexpr int LCAP = 512;
DI unsigned fkey(float f) { const unsigned u = __float_as_uint(f); return u ^ ((unsigned)((int)u >> 31) | 0x80000000u); }
DI float funkey(unsigned k) { return __uint_as_float((k & 0x80000000u) ? (k ^ 0x80000000u) : ~k); }
DI int lane_prefix(unsigned long long m) { return (int)__builtin_amdgcn_mbcnt_hi((unsigned)(m >> 32), __builtin_amdgcn_mbcnt_lo((unsigned)m, 0u)); }

DI float select256(LAS float* lv, LAS unsigned short* li, int cnt, int lane) {
    lds_fence();
    unsigned ku[8]; unsigned id[8];
    unsigned kmin = 0xffffffffu, kmax = 0u;
#pragma unroll
    for (int e = 0; e < 8; ++e) {
        const int idx = e * 64 + lane; const bool in = idx < cnt;
        const float v = lv[in ? idx : 0]; id[e] = li[in ? idx : 0];
        ku[e] = in ? fkey(v) : 0u;
        kmin = in ? (ku[e] < kmin ? ku[e] : kmin) : kmin; kmax = ku[e] > kmax ? ku[e] : kmax;
    }
#pragma unroll
    for (int o = 32; o >= 1; o >>= 1) { const unsigned a = shxu(kmin, o, lane), b = shxu(kmax, o, lane); kmin = a < kmin ? a : kmin; kmax = b > kmax ? b : kmax; }
    unsigned lo = __builtin_amdgcn_readfirstlane(kmin), hi = __builtin_amdgcn_readfirstlane(kmax) + 1u;
    while (hi - lo > 1u) {
        const unsigned mid = lo + ((hi - lo) >> 1);
        int c = 0;
#pragma unroll
        for (int e = 0; e < 8; ++e) c += __popcll(__ballot(ku[e] >= mid));
        if (c >= TOPK) lo = mid; else hi = mid;
        if (c == TOPK) break;
    }
    const unsigned tk = lo;
    int ngt = 0;
#pragma unroll
    for (int e = 0; e < 8; ++e) ngt += __popcll(__ballot(ku[e] > tk));
    const int need = TOPK - ngt;
    int base = 0, eqbase = 0;
    lds_fence();
#pragma unroll
    for (int e = 0; e < 8; ++e) {
        const bool eq = ku[e] == tk; const unsigned long long meq = __ballot(eq);
        const int eqrank = eqbase + lane_prefix(meq);
        const bool keep = (ku[e] > tk) || (eq && eqrank < need);
        const unsigned long long mk = __ballot(keep);
        const int pos = base + lane_prefix(mk);
        if (keep) { lv[pos] = funkey(ku[e]); li[pos] = (unsigned short)id[e]; }
        base += __popcll(mk); eqbase += __popcll(meq);
    }
    lds_fence();
    return funkey(tk);
}

DI void idx_phase(const bf16_t* QI, const bf16_t* KI, const float* WI, unsigned short* SEL, int* NSEL, LAS unsigned char* lds, int tid, int bid, int G) {
    const int lane = tid & 63, wave = __builtin_amdgcn_readfirstlane(tid >> 6), gw = bid * NWAVES + wave, W = G * NWAVES;
    LAS float* LV = (LAS float*)(lds + wave * 12288); LAS unsigned short* LI = (LAS unsigned short*)(lds + wave * 12288 + 8192);
    const int h = lane >> 5, r = lane & 31;
    constexpr int NU = S / 4;
    for (int i0 = gw; i0 < NU / 2; i0 += W)
        for (int rep = 0; rep < 2; ++rep) {
            const int u = rep ? (NU - 1 - i0) : i0, t0 = 4 * u;
            bf16x8 af[2][4]; float wv[2][16];
#pragma unroll
            for (int p = 0; p < 2; ++p) {
                const int qsel = (r >> 2) & 1, hd = (r & 3) + 4 * (r >> 3);
                const bf16_t* qp = QI + ((size_t)(t0 + 2 * p + qsel) * IH + hd) * ID + 8 * h;
#pragma unroll
                for (int ks = 0; ks < 4; ++ks) af[p][ks] = *(const bf16x8*)(qp + 16 * ks);
                const f32x4* wp = (const f32x4*)(WI + (size_t)(t0 + 2 * p + h) * IH);
#pragma unroll
                for (int j = 0; j < 4; ++j) { const f32x4 w4 = wp[j]; wv[p][4 * j] = w4[0]; wv[p][4 * j + 1] = w4[1]; wv[p][4 * j + 2] = w4[2]; wv[p][4 * j + 3] = w4[3]; }
            }
            int cnt[4] = {0, 0, 0, 0}; float tau[4];
#pragma unroll
            for (int q = 0; q < 4; ++q) tau[q] = -__builtin_inff();
            const int ntile = (t0 + 3) / 32 + 1;
            for (int kt = 0; kt < ntile; ++kt) {
                bf16x8 bfr[4];
                const bf16_t* kp = KI + (size_t)(32 * kt + r) * ID + 8 * h;
#pragma unroll
                for (int ks = 0; ks < 4; ++ks) bfr[ks] = *(const bf16x8*)(kp + 16 * ks);
#pragma unroll
                for (int p = 0; p < 2; ++p) {
                    f32x16 acc;
#pragma unroll
                    for (int j = 0; j < 16; ++j) acc[j] = 0.f;
#pragma unroll
                    for (int ks = 0; ks < 4; ++ks) acc = MFMA32(af[p][ks], bfr[ks], acc);
                    float sc = 0.f;
#pragma unroll
                    for (int j = 0; j < 16; ++j) sc = fmaf(wv[p][j], fmaxf(acc[j], 0.f), sc);
                    sc += 0.0f;
                    const int key = 32 * kt + r, tq = t0 + 2 * p + h;
                    const float tauv = h ? tau[2 * p + 1] : tau[2 * p];
                    const bool pass = (key <= tq) && (sc > tauv);
                    const unsigned long long mask = __ballot(pass);
                    if (mask != 0ull) {
                        const unsigned mlo = (unsigned)mask, mhi = (unsigned)(mask >> 32);
                        const unsigned mym = h ? mhi : mlo;
                        const int slot = (h ? cnt[2 * p + 1] : cnt[2 * p]) + __popc(mym & ((1u << r) - 1u));
                        if (pass) { LV[(2 * p + h) * LCAP + slot] = sc; LI[(2 * p + h) * LCAP + slot] = (unsigned short)key; }
                        cnt[2 * p] += __popc(mlo); cnt[2 * p + 1] += __popc(mhi);
                    }
                }
#pragma unroll
                for (int q = 0; q < 4; ++q)
                    if (cnt[q] > LCAP - 32) { tau[q] = select256(LV + q * LCAP, LI + q * LCAP, cnt[q], lane); cnt[q] = TOPK; }
            }
#pragma unroll
            for (int q = 0; q < 4; ++q) {
                if (cnt[q] > TOPK) { (void)select256(LV + q * LCAP, LI + q * LCAP, cnt[q], lane); cnt[q] = TOPK; }
                lds_fence();
                const int t = t0 + q;
#pragma unroll
                for (int j = 0; j < 4; ++j) { const int idx = j * 64 + lane; SEL[(size_t)t * TOPK + idx] = idx < cnt[q] ? LI[q * LCAP + idx] : (unsigned short)0; }
                if (lane == 0) NSEL[t] = cnt[q];
            }
            lds_fence();
        }
}

typedef unsigned v4u32 __attribute__((ext_vector_type(4)));
DI const bf16_t* uni_ptr(const bf16_t* p) { const unsigned long long v = (unsigned long long)p; const unsigned lo = __builtin_amdgcn_readfirstlane((unsigned)v), hi = __builtin_amdgcn_readfirstlane((unsigned)(v >> 32)); return (const bf16_t*)(((unsigned long long)hi << 32) | lo); }
DI bf16x8 bload(__amdgpu_buffer_rsrc_t rs, unsigned voff, unsigned soff) { return __builtin_bit_cast(bf16x8, __builtin_amdgcn_raw_buffer_load_b128(rs, voff, soff, 0)); }
DI void attn_item(const bf16_t* qrow, const bf16_t* Kblk_, int ldk_, const bf16_t* Vt_, bool causal, int kbase, int tq, int lane, f32x16 (&oacc)[4], float& mlog, float& lsum) {
    const int r = lane & 31, h = lane >> 5;
    const unsigned ldk = (unsigned)__builtin_amdgcn_readfirstlane(ldk_);
    const __amdgpu_buffer_rsrc_t rsK = __builtin_amdgcn_make_buffer_rsrc((void*)uni_ptr(Kblk_), (short)0, (int)(MBLK * ldk * 2u), 0x00020000);
    const __amdgpu_buffer_rsrc_t rsV = __builtin_amdgcn_make_buffer_rsrc((void*)uni_ptr(Vt_), (short)0, HD * MBLK * 2, 0x00020000);
    const unsigned voffK = ((unsigned)r * ldk + 8u * h) * 2u, voffV = ((unsigned)r * MBLK + 8u * h) * 2u;
    bf16x8 qf[8];
#pragma unroll
    for (int ks = 0; ks < 8; ++ks) qf[ks] = *(const bf16x8*)(qrow + 16 * ks + 8 * h);
    f32x16 sacc[8];
#pragma unroll
    for (int mt = 0; mt < 8; ++mt) {
#pragma unroll
        for (int j = 0; j < 16; ++j) sacc[mt][j] = 0.f;
#pragma unroll
        for (int ks = 0; ks < 8; ++ks) { const bf16x8 a = bload(rsK, voffK, (32u * mt * ldk + 16u * ks) * 2u); sacc[mt] = MFMA32(a, qf[ks], sacc[mt]); }
        if (mt & 1) __builtin_amdgcn_sched_barrier(0);
    }
    __builtin_amdgcn_sched_barrier(0);
    float mx = -__builtin_inff();
#pragma unroll
    for (int mt = 0; mt < 8; ++mt)
#pragma unroll
        for (int j = 0; j < 16; ++j) {
            const int key = 32 * mt + (j & 3) + 8 * (j >> 2) + 4 * h;
            float s = sacc[mt][j];
            if (causal && (kbase + key > tq)) s = -__builtin_inff();
            sacc[mt][j] = s; mx = fmaxf(mx, s);
        }
    mx = fmaxf(mx, shx(mx, 32, lane));
    mlog = mx * ATT_SC;
    float l = 0.f;
    u32x4 pw[8][2];
#pragma unroll
    for (int mt = 0; mt < 8; ++mt)
#pragma unroll
        for (int s2 = 0; s2 < 2; ++s2) {
            float p[8];
#pragma unroll
            for (int j = 0; j < 8; ++j) { p[j] = __builtin_amdgcn_exp2f(sacc[mt][8 * s2 + j] * ATT_SC - mlog); l += p[j]; }
            pw[mt][s2].x = pk_bf16(p[0], p[1]); pw[mt][s2].y = pk_bf16(p[2], p[3]); pw[mt][s2].z = pk_bf16(p[4], p[5]); pw[mt][s2].w = pk_bf16(p[6], p[7]);
        }
    l += shx(l, 32, lane);
    lsum = l;
#pragma unroll
    for (int dt = 0; dt < 4; ++dt)
#pragma unroll
        for (int j = 0; j < 16; ++j) oacc[dt][j] = 0.f;
    __builtin_amdgcn_sched_barrier(0);
#pragma unroll
    for (int mt = 0; mt < 8; ++mt)
#pragma unroll
        for (int s2 = 0; s2 < 2; ++s2) {
            const bf16x8 pb = __builtin_bit_cast(bf16x8, pw[mt][s2]);
#pragma unroll
            for (int dt = 0; dt < 4; ++dt) {
                const bf16x8 a = bload(rsV, voffV, (unsigned)((32 * dt * MBLK + 32 * mt + 16 * s2) * 2));
                oacc[dt] = MFMA32(a, pb, oacc[dt]);
            }
            if (s2) __builtin_amdgcn_sched_barrier(0);
        }
}

DI void memattn_item(int item, int L, const bf16_t* QM, const bf16_t* MEMK, const bf16_t* MEMVT, bf16_t* AO, int lane) {
    const int hm = item & 3, t = (item >> 2) * 32 + (lane & 31), h = lane >> 5;
    f32x16 oacc[4]; float mlog, l;
    const int ldk = HD;
    attn_item(QM + ((size_t)t * NMH + hm) * HD, MEMK + (size_t)(L * NMH + hm) * NMEM * HD, ldk, MEMVT + (size_t)(L * NMH + hm) * HD * NMEM, false, 0, 0, lane, oacc, mlog, l);
    const float inv = 1.0f / l;
    bf16_t* op = AO + (size_t)t * D + NH * HD + hm * HD;
#pragma unroll
    for (int dt = 0; dt < 4; ++dt)
#pragma unroll
        for (int q4 = 0; q4 < 4; ++q4) {
            u32x2 w; w.x = pk_bf16(oacc[dt][4 * q4] * inv, oacc[dt][4 * q4 + 1] * inv); w.y = pk_bf16(oacc[dt][4 * q4 + 2] * inv, oacc[dt][4 * q4 + 3] * inv);
            *(u32x2*)(op + 32 * dt + 8 * q4 + 4 * h) = w;
        }
}

DI void dsa_query(int t, const bf16_t* Q, const bf16_t* Kb, const bf16_t* Vb, const unsigned short* SEL, const int* NSEL, bf16_t* AO, LAS unsigned char* wl, int lane) {
    LAS float* Pl = (LAS float*)wl;
    LAS unsigned short* selL = (LAS unsigned short*)(wl + 4096);
    LAS float* linv = (LAS float*)(wl + 4096 + 512);
    const int ns = NSEL[t];
    {
        const u32x2 sv = *(const u32x2*)(SEL + (size_t)t * TOPK + 4 * lane);
        *(LAS u32x2*)(selL + 4 * lane) = sv;
    }
    lds_fence();
    const int c = lane & 15, kq = lane >> 4;
    bf16x8 qf[4];
#pragma unroll
    for (int ks = 0; ks < 4; ++ks) {
        bf16x8 z; for (int j = 0; j < 8; ++j) z[j] = 0;
        qf[ks] = c < NH ? *(const bf16x8*)(Q + ((size_t)t * NH + c) * HD + 32 * ks + 8 * kq) : z;
    }
    for (int g = 0; g < NKV; ++g) {
        f32x4 sacc[16];
#pragma unroll
        for (int j = 0; j < 16; ++j) {
            const int kidx = selL[16 * j + c];
            const bf16_t* kp = Kb + ((size_t)kidx * NKV + g) * HD + 8 * kq;
            sacc[j] = (f32x4){0.f, 0.f, 0.f, 0.f};
#pragma unroll
            for (int ks = 0; ks < 4; ++ks) { const bf16x8 a = *(const bf16x8*)(kp + 32 * ks); sacc[j] = MFMA16(a, qf[ks], sacc[j]); }
        }
        float mx = -__builtin_inff();
#pragma unroll
        for (int j = 0; j < 16; ++j)
#pragma unroll
            for (int e = 0; e < 4; ++e) { const int slot = 16 * j + 4 * kq + e; const float s = slot < ns ? sacc[j][e] : -__builtin_inff(); sacc[j][e] = s; mx = fmaxf(mx, s); }
        mx = fmaxf(mx, shx(mx, 16, lane)); mx = fmaxf(mx, shx(mx, 32, lane));
        const float ml = mx * ATT_SC; float l = 0.f;
#pragma unroll
        for (int j = 0; j < 16; ++j)
#pragma unroll
            for (int e = 0; e < 4; ++e) { const float p = __builtin_amdgcn_exp2f(sacc[j][e] * ATT_SC - ml); sacc[j][e] = p; l += p; }
        l += shx(l, 16, lane); l += shx(l, 32, lane);
        const int rr = c - 3 * g;
        if (rr >= 0 && rr < 3) {
#pragma unroll
            for (int j = 0; j < 16; ++j)
#pragma unroll
                for (int e = 0; e < 4; ++e) Pl[(16 * j + 4 * kq + e) * 4 + rr] = sacc[j][e];
            if (kq == 0) linv[rr] = 1.0f / l;
        }
        lds_fence();
        float o[3][8];
#pragma unroll
        for (int a = 0; a < 3; ++a)
#pragma unroll
            for (int e = 0; e < 8; ++e) o[a][e] = 0.f;
#pragma unroll 4
        for (int i = 0; i < 64; ++i) {
            const int slot = 4 * i + kq, kidx = selL[slot];
            const u32x4 v = *(const u32x4*)(Vb + ((size_t)kidx * NKV + g) * HD + 8 * c);
            const f32x4 p = *(const LAS f32x4*)(Pl + slot * 4);
            const float vf[8] = {bf_lo(v.x), bf_hi(v.x), bf_lo(v.y), bf_hi(v.y), bf_lo(v.z), bf_hi(v.z), bf_lo(v.w), bf_hi(v.w)};
#pragma unroll
            for (int e = 0; e < 8; ++e) { o[0][e] = fmaf(p[0], vf[e], o[0][e]); o[1][e] = fmaf(p[1], vf[e], o[1][e]); o[2][e] = fmaf(p[2], vf[e], o[2][e]); }
        }
#pragma unroll
        for (int a = 0; a < 3; ++a)
#pragma unroll
            for (int e = 0; e < 8; ++e) { float x = o[a][e]; x += shx(x, 16, lane); x += shx(x, 32, lane); o[a][e] = x; }
        if (kq == 0) {
#pragma unroll
            for (int a = 0; a < 3; ++a) {
                const float iv = linv[a];
                u32x4 w; w.x = pk_bf16(o[a][0] * iv, o[a][1] * iv); w.y = pk_bf16(o[a][2] * iv, o[a][3] * iv); w.z = pk_bf16(o[a][4] * iv, o[a][5] * iv); w.w = pk_bf16(o[a][6] * iv, o[a][7] * iv);
                *(u32x4*)(AO + (size_t)t * D + (3 * g + a) * HD + 8 * c) = w;
            }
        }
        lds_fence();
    }
}

DI void moba_gate_unit(int unit, const bf16_t* Q, const float* KMEAN, unsigned short* ITEMS, int* NITEMS, LAS unsigned char* lds, int tid) {
    const int cur = unit >> 2, g = unit & 3, nv = cur < 3 ? cur : 3;
    LAS float* km = (LAS float*)lds;
    LAS int* bcnt = (LAS int*)(lds + 32768);
    LAS int* boff = bcnt + 64;
    LAS int* ibase = boff + 64;
    LAS int* bfill = ibase + 68;
    LAS unsigned* rowsel = (LAS unsigned*)(bfill + 64);
    LAS unsigned short* sorted = (LAS unsigned short*)(rowsel + 768);
    if (tid < 64) { bcnt[tid] = 0; bfill[tid] = 0; }
    for (int i = tid; i < cur * 32; i += NTHREADS) *(LAS f32x4*)(km + 4 * i) = *(const f32x4*)(KMEAN + (size_t)g * NBLK * HD + 4 * i);
    __syncthreads();
    if (nv > 0) {
        for (int row = tid; row < 768; row += NTHREADS) {
            const int tl = row / 3, rr = row - 3 * tl, t = cur * MBLK + tl;
            const u32x4* qp = (const u32x4*)(Q + ((size_t)t * NH + 3 * g + rr) * HD);
            u32x4 qv[16];
#pragma unroll
            for (int i = 0; i < 16; ++i) qv[i] = qp[i];
            float v0 = -__builtin_inff(), v1 = v0, v2 = v0; int i0 = 0, i1 = 0, i2 = 0;
            for (int n = 0; n < cur; ++n) {
                float dot = 0.f;
#pragma unroll
                for (int i = 0; i < 16; ++i) {
                    const f32x4 ka = *(const LAS f32x4*)(km + n * HD + 8 * i), kb = *(const LAS f32x4*)(km + n * HD + 8 * i + 4);
                    dot = fmaf(bf_lo(qv[i].x), ka[0], dot); dot = fmaf(bf_hi(qv[i].x), ka[1], dot); dot = fmaf(bf_lo(qv[i].y), ka[2], dot); dot = fmaf(bf_hi(qv[i].y), ka[3], dot);
                    dot = fmaf(bf_lo(qv[i].z), kb[0], dot); dot = fmaf(bf_hi(qv[i].z), kb[1], dot); dot = fmaf(bf_lo(qv[i].w), kb[2], dot); dot = fmaf(bf_hi(qv[i].w), kb[3], dot);
                }
                if (dot > v0) { v2 = v1; i2 = i1; v1 = v0; i1 = i0; v0 = dot; i0 = n; }
                else if (dot > v1) { v2 = v1; i2 = i1; v1 = dot; i1 = n; }
                else if (dot > v2) { v2 = dot; i2 = n; }
            }
            rowsel[row] = (unsigned)i0 | ((unsigned)i1 << 8) | ((unsigned)i2 << 16);
            atomicAdd((int*)(bcnt + i0), 1); if (nv > 1) atomicAdd((int*)(bcnt + i1), 1); if (nv > 2) atomicAdd((int*)(bcnt + i2), 1);
        }
    }
    __syncthreads();
    if (tid == 0) { int o = 0, ib = 0; for (int n = 0; n < 64; ++n) { boff[n] = o; ibase[n] = ib; const int c = n < cur ? bcnt[n] : 0; o += c; ib += (c + 31) >> 5; } ibase[64] = ib; }
    __syncthreads();
    if (nv > 0) {
        for (int row = tid; row < 768; row += NTHREADS) {
            const int tl = row / 3, rr = row - 3 * tl; const unsigned rs = rowsel[row];
            for (int j = 0; j < nv; ++j) { const int n = (rs >> (8 * j)) & 255; const int pos = atomicAdd((int*)(bfill + n), 1); sorted[boff[n] + pos] = (unsigned short)((tl << 4) | (rr << 2) | j); }
        }
    }
    __syncthreads();
    const int wave = tid >> 6, lane = tid & 63;
    unsigned short* ib = ITEMS + (size_t)unit * ITEM_CAP * ITEM_U16;
    for (int n = wave; n < cur; n += NWAVES) {
        const int c = bcnt[n], b0 = ibase[n], o0 = boff[n];
        for (int i = lane; i < c; i += 64) ib[(size_t)(b0 + (i >> 5)) * ITEM_U16 + 8 + (i & 31)] = sorted[o0 + i];
        for (int k = lane; k < ((c + 31) >> 5); k += 64) { ib[(size_t)(b0 + k) * ITEM_U16] = (unsigned short)n; const int rem = c - 32 * k; ib[(size_t)(b0 + k) * ITEM_U16 + 1] = (unsigned short)(rem < 32 ? rem : 32); }
    }
    if (tid == 0) NITEMS[unit] = ibase[64];
    __syncthreads();
}

DI void moba_item(int unit, int k, const bf16_t* Q, const bf16_t* Kb, const bf16_t* VT, const unsigned short* ITEMS, const int* NITEMS, bf16_t* PO, float* PML, int lane) {
    const int cur = unit >> 2, g = unit & 3, r = lane & 31, h = lane >> 5;
    int n, count, tl, rr, j; bool causal;
    if (k < ITEM_CAP) {
        if (k >= NITEMS[unit]) return;
        const unsigned short* it = ITEMS + ((size_t)unit * ITEM_CAP + k) * ITEM_U16;
        n = it[0]; count = it[1];
        const unsigned rec = it[8 + (r < count ? r : 0)];
        tl = rec >> 4; rr = (rec >> 2) & 3; j = rec & 3; causal = false;
    } else {
        const int rho = 32 * (k - ITEM_CAP) + r;
        n = cur; count = 32; tl = rho / 3; rr = rho - 3 * tl; j = 3; causal = true;
    }
    const int t = cur * MBLK + tl, hq = 3 * g + rr;
    f32x16 oacc[4]; float mlog, l;
    attn_item(Q + ((size_t)t * NH + hq) * HD, Kb + ((size_t)n * MBLK * NKV + g) * HD, NKV * HD, VT + (size_t)(g * NBLK + n) * HD * MBLK, causal, n * MBLK, t, lane, oacc, mlog, l);
    if (r < count) {
        const size_t slot = ((size_t)t * NH + hq) * 4 + j;
        const float inv = 1.0f / l;
        bf16_t* op = PO + slot * HD;
#pragma unroll
        for (int dt = 0; dt < 4; ++dt)
#pragma unroll
            for (int q4 = 0; q4 < 4; ++q4) {
                u32x2 w; w.x = pk_bf16(oacc[dt][4 * q4] * inv, oacc[dt][4 * q4 + 1] * inv); w.y = pk_bf16(oacc[dt][4 * q4 + 2] * inv, oacc[dt][4 * q4 + 3] * inv);
                *(u32x2*)(op + 32 * dt + 8 * q4 + 4 * h) = w;
            }
        if (h == 0) { f32x2 ml = {mlog, l}; *(f32x2*)(PML + slot * 2) = ml; }
    }
}

DI void moba_merge(const bf16_t* PO, const float* PML, bf16_t* AO, int gtid, int GT) {
    for (int it = gtid; it < S * NH * 16; it += GT) {
        const int c = it & 15, th = it >> 4, t = th / NH, hq = th - t * NH;
        const int cur = t >> 8, nv = cur < 3 ? cur : 3;
        float mj[4], lj[4]; float M = -__builtin_inff();
#pragma unroll
        for (int j = 0; j < 4; ++j) {
            const bool valid = (j == 3) || (j < nv);
            const f32x2 ml = valid ? *(const f32x2*)(PML + ((size_t)th * 4 + j) * 2) : (f32x2){-__builtin_inff(), 0.f};
            mj[j] = ml[0]; lj[j] = ml[1]; M = fmaxf(M, mj[j]);
        }
        float o[8], wsum = 0.f;
#pragma unroll
        for (int e = 0; e < 8; ++e) o[e] = 0.f;
#pragma unroll
        for (int j = 0; j < 4; ++j) {
            const bool valid = (j == 3) || (j < nv);
            if (valid) {
                const float w = lj[j] * __builtin_amdgcn_exp2f(mj[j] - M); wsum += w;
                const u32x4 v = *(const u32x4*)(PO + ((size_t)th * 4 + j) * HD + 8 * c);
                o[0] = fmaf(w, bf_lo(v.x), o[0]); o[1] = fmaf(w, bf_hi(v.x), o[1]); o[2] = fmaf(w, bf_lo(v.y), o[2]); o[3] = fmaf(w, bf_hi(v.y), o[3]);
                o[4] = fmaf(w, bf_lo(v.z), o[4]); o[5] = fmaf(w, bf_hi(v.z), o[5]); o[6] = fmaf(w, bf_lo(v.w), o[6]); o[7] = fmaf(w, bf_hi(v.w), o[7]);
            }
        }
        const float inv = 1.0f / wsum;
        u32x4 w; w.x = pk_bf16(o[0] * inv, o[1] * inv); w.y = pk_bf16(o[2] * inv, o[3] * inv); w.z = pk_bf16(o[4] * inv, o[5] * inv); w.w = pk_bf16(o[6] * inv, o[7] * inv);
        *(u32x4*)(AO + (size_t)t * D + hq * HD + 8 * c) = w;
    }
}
#ifndef MK_ONE_LAUNCH
#define MK_ONE_LAUNCH 0
#endif
struct Args {
    const float* in[19]; float* out; unsigned char* ws; int ph_lo, ph_hi;
};
static_assert(sizeof(Args) == 176, "Args layout");
enum { I_X = 0, I_MEM, I_POS, I_F1N, I_F1GU, I_F1DN, I_ATN, I_MEMN, I_AWIN, I_IKN, I_BWIN, I_WMKV, I_WOUT, I_F2N, I_F2GU, I_F2DN, I_KVN, I_WKV, I_FINN };
#define CAS __attribute__((address_space(4)))

__global__ void __launch_bounds__(NTHREADS, 2) fwd(Args a_unused) {
    extern __shared__ __attribute__((aligned(16))) unsigned char lds_raw[];
    LAS unsigned char* lds = (LAS unsigned char*)lds_raw;
    const int bid = blockIdx.x, G = gridDim.x, W = G * NWAVES, GT = G * NTHREADS;
    volatile LAS unsigned* misc = (volatile LAS unsigned*)(lds + STAGE_LDS);
    if (threadIdx.x < 4) misc[threadIdx.x] = 0u;
    __syncthreads();
    const int wave_s = __builtin_amdgcn_readfirstlane(threadIdx.x >> 6);
    int lo, hi;
    XcdBarrier bar;
    {
        const CAS char* kp = (const CAS char*)__builtin_amdgcn_kernarg_segment_ptr();
        lo = *(const CAS int*)(kp + 168); hi = *(const CAS int*)(kp + 172);
        unsigned* bw = (unsigned*)(*(unsigned char* const CAS*)(kp + 160) + WS_CTL);
        bar.bar = bw; bar.x = 0; bar.st = misc;
        if (hi - lo > 1) bar = xcd_barrier_post(bw, misc);
    }
    int pid = 0;
#define IN_PHASE (pid >= lo && pid < hi)
#define END_PHASE do { if (pid >= lo && pid + 1 < hi) xcd_barrier(bar); ++pid; } while (0)
#define PV int lane_o; asm volatile("v_mbcnt_lo_u32_b32 %0, -1, 0\n\tv_mbcnt_hi_u32_b32 %0, -1, %0" : "=v"(lane_o)); const int lane = lane_o, wave = wave_s, tid = wave * 64 + lane, gw = bid * NWAVES + wave, gtid = bid * NTHREADS + tid; \
    (void)lane; (void)gw; (void)gtid; (void)wave; \
    const CAS char* kp = (const CAS char*)__builtin_amdgcn_kernarg_segment_ptr(); asm volatile("" : "+s"(kp)); \
    unsigned char* const ws = *(unsigned char* const CAS*)(kp + 160); float* const X = *(float* const CAS*)(kp + 152); (void)ws; (void)X;
#define INP(i) (*(const float* const CAS*)(kp + 8 * (i)))
#define P_COS ((float*)(ws + WS_ROPE))
#define P_SIN ((float*)(ws + WS_ROPE) + (size_t)S * 64)
#define P_H ((bf16_t*)(ws + WS_H))
#define P_ACT ((bf16_t*)(ws + WS_ACT))
#define P_AO ((bf16_t*)(ws + WS_AO))
#define P_Q ((bf16_t*)(ws + WS_Q))
#define P_K ((bf16_t*)(ws + WS_K))
#define P_V ((bf16_t*)(ws + WS_V))
#define P_QI ((bf16_t*)(ws + WS_QI))
#define P_VT ((bf16_t*)(ws + WS_QI))
#define P_KI ((bf16_t*)(ws + WS_KI))
#define P_WI ((float*)(ws + WS_WI))
#define P_QM ((bf16_t*)(ws + WS_QM))
#define P_SEL ((unsigned short*)(ws + WS_SEL))
#define P_NSEL ((int*)(ws + WS_NSEL))
#define P_MEMK ((bf16_t*)(ws + WS_MEMK))
#define P_MEMVT ((bf16_t*)(ws + WS_MEMVT))
#define P_KMEAN ((float*)(ws + WS_KMEAN))
#define P_ITEMS ((unsigned short*)(ws + WS_ITEMS))
#define P_NITEMS ((int*)(ws + WS_NITEMS))
#define P_PO ((bf16_t*)(ws + WS_PO))
#define P_PML ((float*)(ws + WS_PML))
#define P_WGU(i) ((bf16_t*)(ws + ((i) ? WS_WGU1 : WS_WGU0)))
#define P_WDN(i) ((bf16_t*)(ws + ((i) ? WS_WDN1 : WS_WDN0)))
#define P_WIN ((bf16_t*)(ws + WS_WIN))
#define P_WOUT ((bf16_t*)(ws + WS_WOUT))
#define P_WKV ((bf16_t*)(ws + WS_WKV))

    for (int f = 0; f < 4; ++f) {
        const int L = f >> 1; const bool first = (f & 1) == 0;
        if (first) {
            if (IN_PHASE) { PV
                LAS float* tile = (LAS float*)lds;
                if (L == 0) {
                    const int* pos = (const int*)INP(I_POS); float* cs = P_COS; float* sn = P_SIN;
                    for (int e = gtid; e < S * 64; e += GT) {
                        const int t = e >> 6, i = e & 63;
                        const float inv = exp2f(-(float)i * (13.287712379549449f / 64.0f));
                        const float ang = (float)pos[t] * inv;
                        double rev = (double)ang * 0.15915494309189535; rev -= __builtin_rint(rev);
                        const float rf = (float)rev;
                        cs[e] = __builtin_amdgcn_cosf(rf); sn[e] = __builtin_amdgcn_sinf(rf);
                    }
                    for (int unit = bid; unit < 64; unit += G) memkv_unit(unit, INP(I_MEM), INP(I_MEMN), INP(I_WMKV), P_MEMK, P_MEMVT, (LAS float*)lds, tid);
                }
                conv_task(INP(I_F1GU) + (size_t)L * D * NGU, P_WGU(0), NGU, D, NGU, CT_GU, tile, tid, bid, G);
                conv_task(INP(I_F1DN) + (size_t)L * FF * D, P_WDN(0), D, FF, D, CT_ID, tile, tid, bid, G);
                conv_task(INP(I_F2GU) + (size_t)L * D * NGU, P_WGU(1), NGU, D, NGU, CT_GU, tile, tid, bid, G);
                conv_task(INP(I_F2DN) + (size_t)L * FF * D, P_WDN(1), D, FF, D, CT_ID, tile, tid, bid, G);
                conv_task(INP(I_WOUT) + (size_t)L * D * D, P_WOUT, D, D, D, CT_ID, tile, tid, bid, G);
                if (L == 0) conv_task(INP(I_AWIN), P_WIN, A_IN, D, NPA, CT_WINA, tile, tid, bid, G);
                else { conv_task(INP(I_BWIN), P_WIN, B_IN, D, B_IN, CT_WINB, tile, tid, bid, G); conv_task(INP(I_WKV), P_WKV, KVW, D, KVW, CT_WKV, tile, tid, bid, G); }
            }
            END_PHASE;
        }
        if (IN_PHASE) { PV
            const float* gn = (first ? INP(I_F1N) : INP(I_F2N)) + (size_t)L * D;
            norm_rows(f == 0 ? INP(I_X) : X, gn, P_H, f == 2 ? INP(I_KVN) : nullptr, P_AO, gw, W, lane);
        }
        END_PHASE;
        if (f == 2) {
            if (IN_PHASE) { PV
                pg8::Gemm g{P_AO, P_WKV, S, KVW, D}; pg8::StaticOrder so; so.init(S, KVW, G, bid);
                EpiProj<2> E{P_Q, P_K, P_V, P_QI, P_KI, P_QM, P_WI, P_COS, P_SIN, INP(I_IKN)};
                pg8::gemm_phase<EpiProj<2>, pg8::StaticOrder, false>(lds, g, so, E, nullptr, tid);
            }
            END_PHASE;
            if (IN_PHASE) { PV for (int unit = bid; unit < 256; unit += G) kvpost_unit(unit, P_K, P_V, P_KMEAN, P_VT, lds, tid); }
            END_PHASE;
        }
        if (IN_PHASE) { PV
            pg8::Gemm g{P_H, P_WGU(f & 1), S, NGU, D}; pg8::StaticOrder so; so.init(S, NGU, G, bid);
            EpiSwiglu E{P_ACT};
            pg8::gemm_phase<EpiSwiglu, pg8::StaticOrder, false>(lds, g, so, E, nullptr, tid);
        }
        END_PHASE;
        if (IN_PHASE) { PV
            pg8::Gemm g{P_ACT, P_WDN(f & 1), S, D, FF}; pg8::StaticOrder so; so.init(S, D, G, bid);
            EpiResid E{f == 0 ? INP(I_X) : X, X, 0.5f};
            pg8::gemm_phase<EpiResid, pg8::StaticOrder, false>(lds, g, so, E, nullptr, tid);
        }
        END_PHASE;
        if (!first) continue;
        if (IN_PHASE) { PV norm_rows(X, INP(I_ATN) + (size_t)L * D, P_H, nullptr, nullptr, gw, W, lane); }
        END_PHASE;
        if (L == 0) {
            if (IN_PHASE) { PV
                pg8::Gemm g{P_H, P_WIN, S, NPA, D}; pg8::StaticOrder so; so.init(S, NPA, G, bid);
                EpiProj<0> E{P_Q, P_K, P_V, P_QI, P_KI, P_QM, P_WI, P_COS, P_SIN, INP(I_IKN)};
                pg8::gemm_phase<EpiProj<0>, pg8::StaticOrder, false>(lds, g, so, E, nullptr, tid);
            }
            END_PHASE;
            if (IN_PHASE) { PV idx_phase(P_QI, P_KI, P_WI, P_SEL, P_NSEL, lds, tid, bid, G); }
            END_PHASE;
            if (IN_PHASE) { PV
                for (int item = gw; item < (S / 32) * NMH; item += W) memattn_item(item, 0, P_QM, P_MEMK, P_MEMVT, P_AO, lane);
                for (int t = gw; t < S; t += W) dsa_query(t, P_Q, P_K, P_V, P_SEL, P_NSEL, P_AO, lds + wave * 5120, lane);
            }
            END_PHASE;
        } else {
            if (IN_PHASE) { PV
                pg8::Gemm g{P_H, P_WIN, S, B_IN, D}; pg8::StaticOrder so; so.init(S, B_IN, G, bid);
                EpiProj<1> E{P_Q, P_K, P_V, P_QI, P_KI, P_QM, P_WI, P_COS, P_SIN, INP(I_IKN)};
                pg8::gemm_phase<EpiProj<1>, pg8::StaticOrder, false>(lds, g, so, E, nullptr, tid);
            }
            END_PHASE;
            if (IN_PHASE) { PV for (int unit = bid; unit < 256; unit += G) moba_gate_unit(unit, P_Q, P_KMEAN, P_ITEMS, P_NITEMS, lds, tid); }
            END_PHASE;
            if (IN_PHASE) { PV
                for (int item = gw; item < (S / 32) * NMH; item += W) memattn_item(item, 1, P_QM, P_MEMK, P_MEMVT, P_AO, lane);
                for (int sl = gw; sl < 256 * SLOTS_PER_UNIT; sl += W) moba_item(sl & 255, sl >> 8, P_Q, P_K, P_VT, P_ITEMS, P_NITEMS, P_PO, P_PML, lane);
            }
            END_PHASE;
            if (IN_PHASE) { PV moba_merge(P_PO, P_PML, P_AO, gtid, GT); }
            END_PHASE;
        }
        if (IN_PHASE) { PV
            pg8::Gemm g{P_AO, P_WOUT, S, D, D}; pg8::StaticOrder so; so.init(S, D, G, bid);
            EpiResid E{X, X, 1.0f};
            pg8::gemm_phase<EpiResid, pg8::StaticOrder, false>(lds, g, so, E, nullptr, tid);
        }
        END_PHASE;
    }
    if (IN_PHASE) { PV final_norm_rows(X, INP(I_FINN), gw, W, lane); }
    END_PHASE;
#undef IN_PHASE
#undef END_PHASE
}
constexpr int N_PHASES = 9 + 3 + 12 + 3 + 1;

extern "C" void kernel_launch(void* const* d_in, const int* in_sizes, int n_in, void* d_out, int out_size, void* d_ws, size_t ws_size, hipStream_t stream) {
    static int grid = 0;
    if (grid == 0) {
        if (n_in != 19 || out_size != S * D || ws_size < WS_END) { fprintf(stderr, "kernel_launch: unexpected shapes (n_in %d out %d ws %zu need %zu)\n", n_in, out_size, ws_size, (size_t)WS_END); grid = -1; return; }
        int dev = 0, cus = 0, per_cu = 0;
        if (hipGetDevice(&dev) != hipSuccess || hipDeviceGetAttribute(&cus, hipDeviceAttributeMultiprocessorCount, dev) != hipSuccess) { grid = -1; return; }
        if (hipFuncSetAttribute((const void*)fwd, hipFuncAttributeMaxDynamicSharedMemorySize, LDS_BYTES) != hipSuccess) { fprintf(stderr, "kernel_launch: hipFuncSetAttribute failed\n"); grid = -1; return; }
        if (hipOccupancyMaxActiveBlocksPerMultiprocessor(&per_cu, (const void*)fwd, NTHREADS, LDS_BYTES) != hipSuccess || per_cu < 1) { fprintf(stderr, "kernel_launch: occupancy query says %d\n", per_cu); (void)hipGetLastError(); grid = -1; return; }
        grid = cus;
    }
    if (grid < 0) return;
    (void)hipMemsetAsync((char*)d_ws + WS_CTL, 0, CTL_BYTES, stream);
    Args a{};
    for (int i = 0; i < 19; ++i) a.in[i] = (const float*)d_in[i];
    a.out = (float*)d_out; a.ws = (unsigned char*)d_ws;
#if MK_ONE_LAUNCH
    a.ph_lo = 0; a.ph_hi = N_PHASES;
    hipLaunchKernelGGL(fwd, dim3(grid), dim3(NTHREADS), LDS_BYTES, stream, a);
#else
    for (int p = 0; p < N_PHASES; ++p) { a.ph_lo = p; a.ph_hi = p + 1; hipLaunchKernelGGL(fwd, dim3(grid), dim3(NTHREADS), LDS_BYTES, stream, a); }
#endif
}
```

```cpp
#include <hip/hip_runtime.h>
#include <cstdio>
#include <cstdint>

#define LAS __attribute__((address_space(3)))
#define DI __device__ __forceinline__

constexpr int S = 16384, D = 2048, FF = 5632, NGU = 2 * FF;
constexpr int NH = 12, NKV = 4, NMH = 4, HD = 128, NMEM = 256, IH = 16, ID = 64, TOPK = 256, MBLK = 256, NBLK = S / MBLK;
constexpr int A_IN = 4176, NPA = 4352, B_IN = 2048, KVW = 1024;
constexpr float RMS_EPS = 1e-6f;
constexpr float ATT_SC = 0.08838834764831845f * 1.4426950408889634f;
constexpr float W8_SCALE = 64.0f; constexpr int W8_E8M0 = 0x79797979;
constexpr float ACT8_SCALE = 8.0f;
constexpr float IDX_W_SCALE = 0.25f * 0.125f;
constexpr int NWAVES = 8, NTHREADS = 512;
constexpr int STAGE_LDS = 131072, MISC_LDS = 10240, LDS_BYTES = STAGE_LDS + MISC_LDS;

typedef unsigned short bf16_t;
typedef short bf16x8 __attribute__((ext_vector_type(8)));
typedef float f32x4 __attribute__((ext_vector_type(4)));
typedef float f32x2 __attribute__((ext_vector_type(2)));
typedef float f32x16 __attribute__((ext_vector_type(16)));
typedef unsigned u32x4 __attribute__((ext_vector_type(4)));
typedef unsigned u32x2 __attribute__((ext_vector_type(2)));
typedef __bf16 bf16v2_t __attribute__((ext_vector_type(2)));

DI unsigned pk_bf16(float a, float b) { f32x2 f = {a, b}; bf16v2_t r = __builtin_convertvector(f, bf16v2_t); return __builtin_bit_cast(unsigned, r); }
DI float bf_lo(unsigned u) { return __uint_as_float(u << 16); }
DI float bf_hi(unsigned u) { return __uint_as_float(u & 0xffff0000u); }
DI float shx(float v, int k, int lane) { return __int_as_float(__builtin_amdgcn_ds_bpermute((lane ^ k) << 2, __float_as_int(v))); }
DI unsigned shxu(unsigned v, int k, int lane) { return (unsigned)__builtin_amdgcn_ds_bpermute((lane ^ k) << 2, (int)v); }
DI float wave_sum(float v, int lane) { v += shx(v, 32, lane); v += shx(v, 16, lane); v += shx(v, 8, lane); v += shx(v, 4, lane); v += shx(v, 2, lane); v += shx(v, 1, lane); return v; }
DI void lds_fence() { asm volatile("s_waitcnt lgkmcnt(0)" ::: "memory"); }
DI int rope128_src(int p) { return ((p >> 2) & 1) * 64 + 4 * (p >> 3) + (p & 3); }
DI int rope64_src(int p) { return ((p >> 2) & 1) * 32 + 4 * (p >> 3) + (p & 3); }
DI int kblk_off(int key, int d) { return (((key >> 5) * 8 + (d >> 4)) * 64 + ((d >> 3) & 1) * 32 + (key & 31)) * 8 + (d & 7); }
DI int vt_pos(int key) { return (key & ~12) | ((key & 8) >> 1) | ((key & 4) << 1); }

DI int vtblk_off(int key, int d) { const int pos = vt_pos(key); return ((((d >> 5) * 8 + (pos >> 5)) * 2 + ((pos >> 4) & 1)) * 64 + ((pos >> 3) & 1) * 32 + (d & 31)) * 8 + (pos & 7); }

constexpr size_t AL(size_t x) { return (x + 255) & ~(size_t)255; }
constexpr size_t WS_CTL = 0, CTL_BYTES = 65536;
constexpr size_t ZERO_BYTES = CTL_BYTES;
constexpr size_t WS_ROPE = WS_CTL + CTL_BYTES;
constexpr size_t WS_WGU0 = WS_ROPE + (size_t)S * 64 * 4 * 2;
constexpr size_t WS_WDN0 = WS_WGU0 + (size_t)NGU * D * 2;
constexpr size_t WS_WGU1 = WS_WDN0 + (size_t)D * FF * 2;
constexpr size_t WS_WDN1 = WS_WGU1 + (size_t)NGU * D * 2;
constexpr size_t WS_WIN = WS_WDN1 + (size_t)D * FF * 2;
constexpr size_t WS_WOUT = WS_WIN + (size_t)NPA * D * 2;
constexpr size_t WS_WKV = WS_WOUT + (size_t)D * D * 2;
constexpr size_t WS_H = WS_WKV + (size_t)KVW * D * 2;
constexpr size_t WS_ACT = WS_H + (size_t)S * D * 2;
constexpr size_t WS_AO = WS_ACT + (size_t)S * FF * 2;
constexpr size_t WS_Q = WS_AO + (size_t)S * D * 2;
constexpr size_t WS_K = WS_Q + (size_t)S * NH * HD * 2;
constexpr size_t WS_V = WS_K + (size_t)S * NKV * HD * 2;
constexpr size_t WS_QI = WS_V + (size_t)S * NKV * HD * 2;
constexpr size_t WS_KI = WS_QI + (size_t)S * IH * ID * 2;
constexpr size_t WS_WI = WS_KI + (size_t)S * ID * 2;
constexpr size_t WS_QM = WS_WI + (size_t)S * IH * 4;
constexpr size_t WS_SEL = WS_QM + (size_t)S * NMH * HD * 2;
constexpr size_t WS_NSEL = WS_SEL + (size_t)S * TOPK * 2;
constexpr size_t WS_MEMK = WS_NSEL + (size_t)S * 4;
constexpr size_t WS_MEMVT = WS_MEMK + (size_t)2 * NMH * NMEM * HD * 2;
constexpr size_t WS_KMEAN = WS_MEMVT + (size_t)2 * NMH * NMEM * HD * 2;
constexpr size_t WS_ITEMS = WS_KMEAN + (size_t)NKV * NBLK * HD * 4;
constexpr int ITEM_CAP = 136, ITEM_U16 = 48, OWN_ITEMS = 24, SLOTS_PER_UNIT = ITEM_CAP + OWN_ITEMS;
constexpr size_t WS_NITEMS = WS_ITEMS + (size_t)256 * ITEM_CAP * ITEM_U16 * 2;
constexpr size_t WS_IB = WS_NITEMS + 1024;
constexpr size_t WS_PML = WS_IB + (size_t)256 * 68 * 4;
constexpr size_t WS_SS = WS_PML + (size_t)S * NH * 4 * 2 * 4;
constexpr size_t WS_H8 = WS_SS + (size_t)7 * S * 32 * 4;
constexpr size_t WS_END = WS_H8 + (size_t)S * D;
constexpr size_t WS_PO = WS_ACT;
static_assert((size_t)S * NH * 4 * HD * 2 <= (WS_Q - WS_ACT), "MoBA partials must fit in ACT+AO");
static_assert(WS_END < (size_t)760 * 1024 * 1024, "workspace budget");
#define XB_TMO      128
#define XB_XCNT(j)  (256  + 64 * (j))
#define XB_XSUB(j)  (1280 + 64 * (j))
#define XB_XGEN(j)  (2304 + 64 * (j))
#define XB_TOP      3328
#define XB_TOPGEN   3392
#define XCD_BAR_WORDS 3456
#define XB_SPIN_CAP (1u << 18)

__device__ __forceinline__ unsigned xb_ld(unsigned* p)              { unsigned long long a = (unsigned long long)p; asm volatile("" : "+v"(a)); return __hip_atomic_load((unsigned*)a, __ATOMIC_RELAXED, __HIP_MEMORY_SCOPE_AGENT); }
__device__ __forceinline__ unsigned xb_add(unsigned* p, unsigned v) { unsigned long long a = (unsigned long long)p; asm volatile("" : "+v"(a), "+v"(v)); return __hip_atomic_fetch_add((unsigned*)a, v, __ATOMIC_RELAXED, __HIP_MEMORY_SCOPE_AGENT); }
__device__ __forceinline__ unsigned xb_xcc_id() { return (unsigned)__builtin_amdgcn_s_getreg((3 << 11) | 20) & 0xFu; }
#define XB_SPIN(cond, bar) do { unsigned _sp = 0; while (cond) { __builtin_amdgcn_s_sleep(1); \
    if ((++_sp & 255u) == 0u) { if (xb_ld(&(bar)[XB_TMO])) break; if (_sp > XB_SPIN_CAP) { (void)xb_add(&(bar)[XB_TMO], 1u); break; } } } } while (0)

struct XcdBarrier {
    unsigned* bar; unsigned x;
    volatile LAS unsigned* st;
};

__device__ __forceinline__ XcdBarrier xcd_barrier_post(unsigned* bar, volatile LAS unsigned* st) {
    XcdBarrier b; b.bar = bar; b.x = xb_xcc_id(); b.st = st;
    if (threadIdx.x == 0) (void)xb_add(&bar[XB_XCNT(b.x)], 1u);
    return b;
}
__device__ __forceinline__ void xcd_barrier_complete(unsigned* bar, unsigned x, unsigned& nloc, unsigned& nx) {
    const unsigned G = gridDim.x * gridDim.y * gridDim.z;
    unsigned sum, cnt, mine, sp = 0u;
    for (;;) {
        sum = 0u; cnt = 0u; mine = 0u;
#pragma unroll
        for (unsigned j = 0; j < 16; ++j) { const unsigned c = xb_ld(&bar[XB_XCNT(j)]); sum += c; cnt += (c > 0u) ? 1u : 0u; mine = (j == x) ? c : mine; }
        if (sum == G) break;
        __builtin_amdgcn_s_sleep(1);
        if ((++sp & 255u) == 0u) { if (xb_ld(&bar[XB_TMO])) break; if (sp > XB_SPIN_CAP) { (void)xb_add(&bar[XB_TMO], 1u); break; } }
    }
    nloc = mine > 0u ? mine : 1u; nx = cnt > 0u ? cnt : 1u;
}

__device__ __forceinline__ void xcd_barrier(const XcdBarrier& b) {
    asm volatile("s_waitcnt vmcnt(0)" ::: "memory");
    __syncthreads();
    if (threadIdx.x == 0) {
        unsigned* bar = b.bar;
        __builtin_amdgcn_s_waitcnt(0);
        unsigned nloc = b.st[0], nx = b.st[1];
        if (nloc == 0u) { xcd_barrier_complete(bar, b.x, nloc, nx); b.st[0] = nloc; b.st[1] = nx; }
        const unsigned old = xb_add(&bar[XB_XSUB(b.x)], 1u);
        const unsigned gen = old / nloc;
        if (old + 1u == (gen + 1u) * nloc) {
            __builtin_amdgcn_fence(__ATOMIC_RELEASE, "agent");
            asm volatile("s_waitcnt vmcnt(0)" ::: "memory");
            const unsigned og = xb_add(&bar[XB_TOP], 1u);
            const unsigned tg = og / nx;
            if (og + 1u == (tg + 1u) * nx) xb_add(&bar[XB_TOPGEN], 1u);
            else XB_SPIN(xb_ld(&bar[XB_TOPGEN]) == tg, bar);
            __builtin_amdgcn_fence(__ATOMIC_ACQUIRE, "agent");
            xb_add(&bar[XB_XGEN(b.x)], 1u);
            asm volatile("s_waitcnt vmcnt(0)" ::: "memory");
        } else {
            XB_SPIN(xb_ld(&bar[XB_XGEN(b.x)]) == gen, bar);
            __builtin_amdgcn_fence(__ATOMIC_ACQUIRE, "agent");
            asm volatile("s_waitcnt vmcnt(0)" ::: "memory");
        }
    }
    __syncthreads();
}

namespace pg8 {
#define PG8_LAS __attribute__((address_space(3)))
typedef unsigned short bf16_t;
typedef short bf16x8 __attribute__((ext_vector_type(8)));
typedef float f32x4 __attribute__((ext_vector_type(4)));
typedef unsigned u32x4 __attribute__((ext_vector_type(4)));
constexpr int BM = 256, BK = 64, HALF = 128, HTB = HALF * BK * 2  , STAGE_BYTES = 8 * HTB, NXCD = 8, WGM = 8;

__host__ __device__ __forceinline__ int lds_byte(int r, int c) { const int st = (r >> 4) * 2 + (c >> 5), rr = r & 15, cc = c & 31, ob = rr * 64 + cc * 2; return st * 1024 + (ob ^ (((ob >> 9) & 1) << 5)); }
__host__ __device__ __forceinline__ void stage_rc(int b, int& R, int& C) { const int st = b / 1024, sb = b % 1024, swz = sb ^ (((sb >> 9) & 1) << 5); R = (st >> 1) * 16 + swz / 64; C = (st & 1) * 32 + (swz % 64) / 2; }
__host__ __device__ __forceinline__ int perm32(int rho) { const int n = rho >> 4, i = rho & 15; return 8 * (i >> 2) + 4 * n + (i & 3); }

struct Unit { int pm, pn; };
struct Gemm { const bf16_t* A; const bf16_t* Bt; int M, N, K; };

struct StaticOrder {
    int nM, nN, nwg, G, c;
    __host__ __device__ void init(int M, int N, int G_, int c_) { nM = M / BM; nN = N / BM; nwg = nM * nN; G = G_; c = c_; }
    __host__ __device__ __forceinline__ bool next(int i, Unit& u) const {
        const int L = i * G + c; if (L >= nwg) return false;
        int wgid = (int)L; { const int q = nwg / NXCD, r = nwg % NXCD, xcd = wgid % NXCD, off = wgid / NXCD; wgid = (xcd < r ? xcd * (q + 1) : r * (q + 1) + (xcd - r) * q) + off; }
        const int nig = WGM * nN, gid = wgid / nig, fm = gid * WGM, gsz = (nM - fm) < WGM ? (nM - fm) : WGM;
        u.pm = fm + ((wgid % nig) % gsz); u.pn = (wgid % nig) / gsz; return true;
    }
    __device__ __forceinline__ void a_ready(const Unit&) const {}
    __device__ __forceinline__ void done(const Unit&) const {}
};
__device__ __forceinline__ unsigned cvt_pk_bf16(float lo, float hi) { return pk_bf16(lo, hi); }

#ifndef PG8_EPI_TWICE
#define PG8_EPI_TWICE 0
#endif
template <class Epi, class Sched, bool STAMP = false, bool FP8 = false, int SCALE_W = 0x7F7F7F7F>
__device__ __forceinline__ void gemm_phase(PG8_LAS unsigned char* lds, const Gemm g, const Sched& S, const Epi& E, unsigned long long* stamps, int wave_in) {
    int tid_o; asm volatile("v_mbcnt_lo_u32_b32 %0, -1, 0\n\tv_mbcnt_hi_u32_b32 %0, -1, %0" : "=v"(tid_o)); tid_o += wave_in * 64;
    const int tid = tid_o, wid = __builtin_amdgcn_readfirstlane(tid >> 6), lane = tid & 63, wr = wid >> 2, wc = wid & 3, fr = lane & 15, fq = lane >> 4;
    const int K = g.K, nt = K / BK;
    int ts_lo = 0, ts_hi = 0, nts = 0; const unsigned long long rt_entry = STAMP ? (unsigned long long)wall_clock64() : 0ull;
#define PG8_STAMP() do { if (STAMP && wid == 0 && nts < 64) { const unsigned long long _c = (unsigned long long)clock64(); \
        ts_lo = (lane == nts) ? (int)(unsigned)_c : ts_lo; ts_hi = (lane == nts) ? (int)(unsigned)(_c >> 32) : ts_hi; ++nts; } } while (0)
    PG8_STAMP();
    unsigned voffA[2], voffB[2];
#pragma unroll
    for (int i = 0; i < 2; ++i) { int R, C; stage_rc(tid * 16 + i * 8192, R, C); const int Rb = Epi::PERM ? ((R & ~31) + perm32(R & 31)) : R;
        voffA[i] = (unsigned)(R * K + C) * 2u; voffB[i] = (unsigned)(Rb * K + C) * 2u; }
    const size_t kstep = (size_t)(BK * 2);
    const size_t hstep = (size_t)HALF * K * 2;
    const size_t tstep = 2 * hstep;
    const unsigned ldsw = (unsigned)wid * 1024u;
    const int aoff = lds_byte(wr * 64 + fr, fq * 8), boff = lds_byte(wc * 32 + fr, fq * 8);
#define PG8_SA(b, h) (((b) * 2 + (h)) * HTB)
#define PG8_SB(b, h) ((4 + (b) * 2 + (h)) * HTB)
#define PG8_STAGE(bufoff, gbase, voff) do { const unsigned long long gb64_ = (unsigned long long)(gbase); \
        const unsigned long long gbu_ = ((unsigned long long)(unsigned)__builtin_amdgcn_readfirstlane((int)(gb64_ >> 32)) << 32) | (unsigned)__builtin_amdgcn_readfirstlane((int)gb64_); \
        _Pragma("unroll") for (int _i = 0; _i < 2; ++_i) { unsigned keep_; const unsigned ldsd_ = (unsigned)(unsigned long long)(lds + (bufoff) + ldsw + _i * 8192); \
            asm volatile("s_mov_b32 %0, m0\n\ts_mov_b32 m0, %3\n\ts_nop 0\n\tglobal_load_lds_dwordx4 %1, %2\n\ts_mov_b32 m0, %0" : "=&s"(keep_) : "v"((voff)[_i]), "s"(gbu_), "s"(ldsd_) : "memory"); } } while (0)
#define PG8_LDA(dst, b, h) do { _Pragma("unroll") for (int m = 0; m < 4; ++m) _Pragma("unroll") for (int k = 0; k < 2; ++k) dst[m][k] = *(const PG8_LAS bf16x8*)(lds + PG8_SA(b, h) + aoff + m * 2048 + k * 1024); } while (0)
#define PG8_LDB(dst, b, h) do { _Pragma("unroll") for (int n = 0; n < 2; ++n) _Pragma("unroll") for (int k = 0; k < 2; ++k) dst[n][k] = *(const PG8_LAS bf16x8*)(lds + PG8_SB(b, h) + boff + n * 2048 + k * 1024); } while (0)
typedef int pg8_i32x8 __attribute__((ext_vector_type(8)));
#define PG8_CAT8(x, y) (__builtin_shufflevector(__builtin_bit_cast(u32x4, (x)), __builtin_bit_cast(u32x4, (y)), 0, 1, 2, 3, 4, 5, 6, 7))
#define PG8_MMA(ai, bj, At, Bt) do { __builtin_amdgcn_s_setprio(1); _Pragma("unroll") for (int m = 0; m < 4; ++m) _Pragma("unroll") for (int n = 0; n < 2; ++n) { \
        if constexpr (FP8) { const pg8_i32x8 b8_ = __builtin_bit_cast(pg8_i32x8, PG8_CAT8(Bt[n][0], Bt[n][1])), a8_ = __builtin_bit_cast(pg8_i32x8, PG8_CAT8(At[m][0], At[m][1])); \
            asm("v_mfma_f32_16x16x128_f8f6f4 %0, %1, %2, %0" : "+v"(acc[ai][bj][m][n]) : "v"(b8_), "v"(a8_)); }   \
        else { _Pragma("unroll") for (int k = 0; k < 2; ++k) acc[ai][bj][m][n] = __builtin_amdgcn_mfma_f32_16x16x32_bf16(Bt[n][k], At[m][k], acc[ai][bj][m][n], 0, 0, 0); } } \
        __builtin_amdgcn_s_setprio(0); } while (0)
#define PG8_WAIT_V(n) asm volatile("s_waitcnt vmcnt(" #n ")" ::: "memory")
#define PG8_WAIT_L(n) asm volatile("s_waitcnt lgkmcnt(" #n ")" ::: "memory")
#define PG8_BAR __builtin_amdgcn_s_barrier()
#define PG8_SCHED __builtin_amdgcn_sched_barrier(0)
    Unit cur, nxt; int ui = 0;
    if (!S.next(0, cur)) return;
    f32x4 acc[2][2][4][2];
#pragma unroll
    for (int a = 0; a < 2; ++a)
#pragma unroll
        for (int b = 0; b < 2; ++b)
#pragma unroll
            for (int m = 0; m < 4; ++m)
#pragma unroll
                for (int n = 0; n < 2; ++n) acc[a][b][m][n] = (f32x4){0.f, 0.f, 0.f, 0.f};
    bf16x8 At[4][2], B0[2][2], B1[2][2];
    const char* cA = (const char*)g.A + (size_t)cur.pm * tstep; const char* cB = (const char*)g.Bt + (size_t)cur.pn * tstep;
    S.a_ready(cur);
    PG8_STAGE(PG8_SB(0, 0), cB, voffB); PG8_STAGE(PG8_SA(0, 0), cA, voffA); PG8_STAGE(PG8_SB(0, 1), cB + hstep, voffB); PG8_STAGE(PG8_SA(0, 1), cA + hstep, voffA);
    if (wr == 1) PG8_BAR;
    PG8_WAIT_V(4); PG8_BAR;
    PG8_STAGE(PG8_SB(1, 0), cB + kstep, voffB); PG8_STAGE(PG8_SA(1, 0), cA + kstep, voffA); PG8_STAGE(PG8_SB(1, 1), cB + hstep + kstep, voffB);
    PG8_WAIT_V(6); PG8_BAR;
    PG8_STAMP();
    for (;;) {
        const bool has_next = S.next(ui + 1, nxt);
        const char* nA = has_next ? (const char*)g.A + (size_t)nxt.pm * tstep : cA; const char* nB = has_next ? (const char*)g.Bt + (size_t)nxt.pn * tstep : cB;
        for (int t = 0; t < nt; t += 2) {
            const bool last = (t == nt - 2);
            const char* a1 = cA + (size_t)(t + 1) * kstep;
            const char* a2 = last ? nA : cA + (size_t)(t + 2) * kstep; const char* b2 = last ? nB : cB + (size_t)(t + 2) * kstep;
            const char* a3 = a2 + kstep; const char* b3 = b2 + kstep;
            if (last && has_next) S.a_ready(nxt);
            PG8_LDB(B0, 0, 0); PG8_SCHED; PG8_LDA(At, 0, 0); PG8_STAGE(PG8_SA(1, 1), a1 + hstep, voffA);
            PG8_WAIT_L(8); PG8_BAR; PG8_WAIT_L(0); PG8_MMA(0, 0, At, B0); PG8_BAR; PG8_SCHED;
            PG8_LDB(B1, 0, 1); PG8_STAGE(PG8_SB(0, 0), b2, voffB);
            PG8_BAR; PG8_WAIT_L(0); PG8_MMA(0, 1, At, B1); PG8_BAR;
            PG8_LDA(At, 0, 1); PG8_STAGE(PG8_SA(0, 0), a2, voffA);
            PG8_BAR; PG8_WAIT_L(0); PG8_MMA(1, 0, At, B0); PG8_BAR; PG8_SCHED;
            PG8_STAGE(PG8_SB(0, 1), b2 + hstep, voffB);
            PG8_WAIT_V(6); PG8_BAR; PG8_MMA(1, 1, At, B1); PG8_BAR;
            PG8_LDB(B0, 1, 0); PG8_SCHED; PG8_LDA(At, 1, 0); PG8_STAGE(PG8_SA(0, 1), a2 + hstep, voffA);
            PG8_WAIT_L(8); PG8_BAR; PG8_WAIT_L(0); PG8_MMA(0, 0, At, B0); PG8_BAR; PG8_SCHED;
            PG8_LDB(B1, 1, 1); PG8_STAGE(PG8_SB(1, 0), b3, voffB);
            PG8_BAR; PG8_WAIT_L(0); PG8_MMA(0, 1, At, B1); PG8_BAR;
            PG8_LDA(At, 1, 1); PG8_STAGE(PG8_SA(1, 0), a3, voffA);
            PG8_BAR; PG8_WAIT_L(0); PG8_MMA(1, 0, At, B0); PG8_BAR; PG8_SCHED;
            PG8_STAGE(PG8_SB(1, 1), b3 + hstep, voffB);
            PG8_WAIT_V(6); PG8_BAR; PG8_MMA(1, 1, At, B1); PG8_BAR;
        }
        PG8_STAMP();
        if constexpr (!Epi::AFTER_DRAIN) { { if constexpr (FP8) {
#define PG8_PAD(ai) asm volatile("s_nop 15\n\ts_nop 15" : "+v"(acc[ai][0][0][0]), "+v"(acc[ai][0][0][1]), "+v"(acc[ai][0][1][0]), "+v"(acc[ai][0][1][1]), "+v"(acc[ai][0][2][0]), "+v"(acc[ai][0][2][1]), "+v"(acc[ai][0][3][0]), "+v"(acc[ai][0][3][1]), \
                "+v"(acc[ai][1][0][0]), "+v"(acc[ai][1][0][1]), "+v"(acc[ai][1][1][0]), "+v"(acc[ai][1][1][1]), "+v"(acc[ai][1][2][0]), "+v"(acc[ai][1][2][1]), "+v"(acc[ai][1][3][0]), "+v"(acc[ai][1][3][1]))
              PG8_PAD(0); PG8_PAD(1);
#undef PG8_PAD
          }
          int ln_; asm volatile("v_mbcnt_lo_u32_b32 %0, -1, 0\n\tv_mbcnt_hi_u32_b32 %0, -1, %0" : "=v"(ln_)); E(acc, cur, wr, wc, ln_ & 15, ln_ >> 4); if (PG8_EPI_TWICE && Epi::PROBE2) { int l2_; asm volatile("v_mbcnt_lo_u32_b32 %0, -1, 0\n\tv_mbcnt_hi_u32_b32 %0, -1, %0" : "=v"(l2_)); E(acc, cur, wr, wc, l2_ & 15, l2_ >> 4); } }     S.done(cur); }
        PG8_STAMP();
        if (!has_next) break;
#pragma unroll
        for (int a = 0; a < 2; ++a)
#pragma unroll
            for (int b = 0; b < 2; ++b)
#pragma unroll
                for (int m = 0; m < 4; ++m)
#pragma unroll
                    for (int n = 0; n < 2; ++n) acc[a][b][m][n] = (f32x4){0.f, 0.f, 0.f, 0.f};
        cur = nxt; cA = nA; cB = nB; ++ui;
    }
    PG8_WAIT_V(0);
    if (wr == 0) PG8_BAR;
    PG8_BAR;
    if constexpr (Epi::AFTER_DRAIN) { E.fused(acc, cur, wr, wc, fr, fq, lds, wid, lane); S.done(cur); }
    PG8_STAMP();
    if (STAMP && wid == 0) { stamps[lane] = lane < nts ? (((unsigned long long)(unsigned)ts_hi << 32) | (unsigned)ts_lo) : 0ull;
        if (lane == 62) stamps[62] = rt_entry; if (lane == 63) stamps[63] = (unsigned long long)wall_clock64(); }
#undef PG8_STAMP
#undef PG8_SA
#undef PG8_SB
#undef PG8_STAGE
#undef PG8_LDA
#undef PG8_LDB
#undef PG8_MMA
#undef PG8_CAT8
#undef PG8_WAIT_V
#undef PG8_WAIT_L
#undef PG8_BAR
#undef PG8_SCHED
}
}
using pg8::Unit;
constexpr int BM = pg8::BM, HALF = pg8::HALF;

DI u32x4 pack8(const f32x4 a, const f32x4 b) { u32x4 w; w.x = pk_bf16(a[0], a[1]); w.y = pk_bf16(a[2], a[3]); w.z = pk_bf16(b[0], b[1]); w.w = pk_bf16(b[2], b[3]); return w; }
DI u32x2 pack8_fp8(const f32x4 a, const f32x4 b) {
    int w0 = 0, w1 = 0;
    w0 = __builtin_amdgcn_cvt_pk_fp8_f32(a[0], a[1], w0, false); w0 = __builtin_amdgcn_cvt_pk_fp8_f32(a[2], a[3], w0, true);
    w1 = __builtin_amdgcn_cvt_pk_fp8_f32(b[0], b[1], w1, false); w1 = __builtin_amdgcn_cvt_pk_fp8_f32(b[2], b[3], w1, true);
    u32x2 r; r.x = (unsigned)w0; r.y = (unsigned)w1; return r;
}
DI float silu_mul(float g, float u) { return g * __builtin_amdgcn_rcpf(1.0f + __builtin_amdgcn_exp2f(-1.4426950408889634f * g)) * u; }

DI void row_rs8(const float* SS, int row0, int fq, int ln, float (&rs)[2][4]) {
    f32x4 a[2][4], b[2][4];
#pragma unroll
    for (int ai = 0; ai < 2; ++ai)
#pragma unroll
        for (int m = 0; m < 4; ++m) { const float* p = SS + (size_t)(row0 + ai * HALF + m * 16) * 32 + 8 * fq; a[ai][m] = *(const f32x4*)p; b[ai][m] = *(const f32x4*)(p + 4); }
#pragma unroll
    for (int ai = 0; ai < 2; ++ai)
#pragma unroll
        for (int m = 0; m < 4; ++m) {
            float s = ((a[ai][m][0] + a[ai][m][1]) + (a[ai][m][2] + a[ai][m][3])) + ((b[ai][m][0] + b[ai][m][1]) + (b[ai][m][2] + b[ai][m][3]));
            s += shx(s, 16, ln); s += shx(s, 32, ln);
            rs[ai][m] = rsqrtf(s * (1.0f / D) + RMS_EPS);
        }
}
DI void row_rs4(const float* SS, int rowb, int fq, int ln, float (&rs)[4]) {
    f32x4 a[4], b[4];
#pragma unroll
    for (int m = 0; m < 4; ++m) { const float* p = SS + (size_t)(rowb + m * 16) * 32 + 8 * fq; a[m] = *(const f32x4*)p; b[m] = *(const f32x4*)(p + 4); }
#pragma unroll
    for (int m = 0; m < 4; ++m) {
        float s = ((a[m][0] + a[m][1]) + (a[m][2] + a[m][3])) + ((b[m][0] + b[m][1]) + (b[m][2] + b[m][3]));
        s += shx(s, 16, ln); s += shx(s, 32, ln);
        rs[m] = rsqrtf(s * (1.0f / D) + RMS_EPS);
    }
}
DI float row_rs(const float* SS, int row, int fq, int ln) {
    const f32x4 a = *(const f32x4*)(SS + (size_t)row * 32 + 8 * fq), b = *(const f32x4*)(SS + (size_t)row * 32 + 8 * fq + 4);
    float s = ((a[0] + a[1]) + (a[2] + a[3])) + ((b[0] + b[1]) + (b[2] + b[3]));
    s += shx(s, 16, ln); s += shx(s, 32, ln);
    return rsqrtf(s * (1.0f / D) + RMS_EPS);
}
DI void rs_prepass(const float* SS, int rowbase, LAS float* RSL, int tid) {
#pragma unroll
    for (int i = 0; i < 4; ++i) {
        const int r = tid + 512 * i; const f32x4* p = (const f32x4*)(SS + (size_t)(rowbase + r) * 32);
        f32x4 v[8];
#pragma unroll
        for (int j = 0; j < 8; ++j) v[j] = p[j];
        float s = 0.f;
#pragma unroll
        for (int j = 0; j < 8; ++j) s += (v[j][0] + v[j][1]) + (v[j][2] + v[j][3]);
        RSL[r] = rsqrtf(s * (1.0f / D) + RMS_EPS);
    }
    __syncthreads();
}
template <bool W8, bool O8 = false> struct EpiSwiglu {
    static constexpr bool PROBE2 = false;
    static constexpr bool PERM = true, AFTER_DRAIN = false;
    bf16_t* O; const float* SS; LAS const float* RSL; int rowbase;
    DI void operator()(const f32x4 (&acc)[2][2][4][2], const Unit& u, int wr, int wc, int fr, int fq) const {
        asm volatile("" : "+v"(fr), "+v"(fq));
        const int row0 = u.pm * BM + wr * 64 + fr, col0 = u.pn * HALF + wc * 32 + 8 * fq;
        const bool inl = RSL != nullptr && (unsigned)(u.pm * BM - rowbase) < 2048u;
#pragma unroll
        for (int ai = 0; ai < 2; ++ai) {
            float rs4[4];
            if (inl) {
#pragma unroll
                for (int m = 0; m < 4; ++m) rs4[m] = RSL[row0 + ai * HALF + m * 16 - rowbase];
            } else row_rs4(SS, row0 + ai * HALF, fq, fr + 16 * fq, rs4);
#pragma unroll
            for (int m = 0; m < 4; ++m) {
                const size_t ro = (size_t)(row0 + ai * HALF + m * 16) * FF + col0;
                const float rs = W8 ? rs4[m] * (1.0f / W8_SCALE) : rs4[m];
                const float k1 = -1.4426950408889634f * rs, k2 = O8 ? rs * rs * ACT8_SCALE : rs * rs;
                f32x4 a, b;
#pragma unroll
                for (int e = 0; e < 4; ++e) {
                    const float g0 = acc[ai][0][m][0][e], u0 = acc[ai][1][m][0][e], g1 = acc[ai][0][m][1][e], u1 = acc[ai][1][m][1][e];
                    a[e] = (g0 * u0) * __builtin_amdgcn_rcpf(1.0f + __builtin_amdgcn_exp2f(k1 * g0)) * k2;
                    b[e] = (g1 * u1) * __builtin_amdgcn_rcpf(1.0f + __builtin_amdgcn_exp2f(k1 * g1)) * k2;
                }
                if (O8) *(u32x2*)((unsigned char*)O + ro) = pack8_fp8(a, b);
                else *(u32x4*)(O + ro) = pack8(a, b);
            }
        }
    }
};

template <int HALFSTEP, bool W8 = false> struct EpiResid {
    static constexpr bool PROBE2 = false;
    static constexpr bool PERM = true, AFTER_DRAIN = false;
    static constexpr float scale = (HALFSTEP ? 0.5f : 1.0f) * (W8 ? 1.0f / (W8_SCALE * ACT8_SCALE) : 1.0f);
    bf16_t* XB; unsigned char* XB8; float* SSout;
    DI void operator()(const f32x4 (&acc)[2][2][4][2], const Unit& u, int wr, int wc, int fr, int fq) const {
        asm volatile("" : "+v"(fr), "+v"(fq));
        const int row0 = u.pm * BM + wr * 64 + fr, col0 = u.pn * BM + wc * 32 + 8 * fq, ln = fr + 16 * fq;
#pragma unroll
        for (int ai = 0; ai < 2; ++ai) {
            u32x4 xv[4][2];
#pragma unroll
            for (int m = 0; m < 4; ++m)
#pragma unroll
                for (int bj = 0; bj < 2; ++bj) xv[m][bj] = *(const u32x4*)(XB + (size_t)(row0 + ai * HALF + m * 16) * D + col0 + bj * HALF);
#pragma unroll
            for (int m = 0; m < 4; ++m) {
                const int row = row0 + ai * HALF + m * 16;
                const size_t ro = (size_t)row * D + col0;
                float ss = 0.f;
#pragma unroll
                for (int bj = 0; bj < 2; ++bj) {
                    const u32x4 x = xv[m][bj];
                    const f32x4 x0 = {bf_lo(x.x), bf_hi(x.x), bf_lo(x.y), bf_hi(x.y)}, x1 = {bf_lo(x.z), bf_hi(x.z), bf_lo(x.w), bf_hi(x.w)};
                    const f32x4 y0 = x0 + scale * acc[ai][bj][m][0], y1 = x1 + scale * acc[ai][bj][m][1];
                    *(u32x4*)(XB + ro + bj * HALF) = pack8(y0, y1);
                    if (XB8) *(u32x2*)(XB8 + ro + bj * HALF) = pack8_fp8(y0, y1);
                    ss += ((y0[0] * y0[0] + y0[1] * y0[1]) + (y0[2] * y0[2] + y0[3] * y0[3])) + ((y1[0] * y1[0] + y1[1] * y1[1]) + (y1[2] * y1[2] + y1[3] * y1[3]));
                }
                ss += shx(ss, 16, ln); ss += shx(ss, 32, ln);
                if (fq == 0) SSout[(size_t)row * 32 + u.pn * 4 + wc] = ss;
            }
        }
    }
};

template <int MODE> struct EpiProj {
    static constexpr bool PERM = true, AFTER_DRAIN = false, PROBE2 = MODE == 0;
    bf16_t *Q, *K, *V, *QI, *KI, *QM; float* WI; const float* COS; const float* SIN; const float* kgain; const float* SS; LAS const float* RSL; int rowbase;
    template <bool FP8 = false> DI void rope128_tile(const f32x4 (&acc)[2][2][4][2], bf16_t* dst, int heads_per_row, int head0, int row0, int wc, int fq, const float (&rs8)[2][4]) const {
        const int g = 4 * wc + fq;
#pragma unroll
        for (int ai = 0; ai < 2; ++ai) {
            f32x4 cs[4], sn[4];
#pragma unroll
            for (int m = 0; m < 4; ++m) { const unsigned o = (unsigned)(row0 + ai * HALF + m * 16) * 64u + 4u * g; cs[m] = *(const f32x4*)(COS + o); sn[m] = *(const f32x4*)(SIN + o); }
#pragma unroll
            for (int m = 0; m < 4; ++m) {
                const int row = row0 + ai * HALF + m * 16;
                const f32x4 c = cs[m], s = sn[m];
                const float rs = rs8[ai][m];
#pragma unroll
                for (int bj = 0; bj < 2; ++bj) {
                    const f32x4 x1 = acc[ai][bj][m][0] * rs, x2 = acc[ai][bj][m][1] * rs;
                    const f32x4 y1 = x1 * c - x2 * s, y2 = x1 * s + x2 * c;
                    if (FP8) *(u32x2*)((unsigned char*)dst + ((size_t)row * heads_per_row + head0 + bj) * HD + 8 * g) = pack8_fp8(y1, y2);
                    else *(u32x4*)(dst + ((size_t)row * heads_per_row + head0 + bj) * HD + 8 * g) = pack8(y1, y2);
                }
            }
        }
    }
    template <bool FP8 = false> DI void plain_tile(const f32x4 (&acc)[2][2][4][2], bf16_t* dst, int heads_per_row, int head0, int row0, int wc, int fq, const float (&rs8)[2][4]) const {
        const int p0 = wc * 32 + 8 * fq;
#pragma unroll
        for (int ai = 0; ai < 2; ++ai)
#pragma unroll
            for (int m = 0; m < 4; ++m) {
                const int row = row0 + ai * HALF + m * 16;
                const float rs = rs8[ai][m];
#pragma unroll
                for (int bj = 0; bj < 2; ++bj) {
                    if (FP8) *(u32x2*)((unsigned char*)dst + ((size_t)row * heads_per_row + head0 + bj) * HD + p0) = pack8_fp8(acc[ai][bj][m][0] * rs, acc[ai][bj][m][1] * rs);
                    else *(u32x4*)(dst + ((size_t)row * heads_per_row + head0 + bj) * HD + p0) = pack8(acc[ai][bj][m][0] * rs, acc[ai][bj][m][1] * rs);
                }
            }
    }
    DI void operator()(const f32x4 (&acc)[2][2][4][2], const Unit& u, int wr, int wc, int fr, int fq) const {
        asm volatile("" : "+v"(fr), "+v"(fq));
        const int row0 = u.pm * BM + wr * 64 + fr, pn = u.pn, ln = fr + 16 * fq;
        float rs8[2][4];
        if (RSL != nullptr && (unsigned)(u.pm * BM - rowbase) < 2048u) {
#pragma unroll
            for (int ai = 0; ai < 2; ++ai)
#pragma unroll
                for (int m = 0; m < 4; ++m) rs8[ai][m] = RSL[row0 + ai * HALF + m * 16 - rowbase];
        } else row_rs8(SS, row0, fq, ln, rs8);
        if (MODE == 1) { if (pn < 6) rope128_tile(acc, Q, NH, 2 * pn, row0, wc, fq, rs8); else plain_tile(acc, QM, NMH, 2 * (pn - 6), row0, wc, fq, rs8); return; }
        if (MODE == 2) { if (pn < 2) rope128_tile(acc, K, NKV, 2 * pn, row0, wc, fq, rs8); else plain_tile(acc, V, NKV, 2 * (pn - 2), row0, wc, fq, rs8); return; }
        if (pn < 6) { rope128_tile(acc, Q, NH, 2 * pn, row0, wc, fq, rs8); return; }
        if (pn < 8) { rope128_tile<true>(acc, K, NKV, 2 * (pn - 6), row0, wc, fq, rs8); return; }
        if (pn < 10) { plain_tile<true>(acc, V, NKV, 2 * (pn - 8), row0, wc, fq, rs8); return; }
        if (pn >= 14 && pn < 16) { plain_tile(acc, QM, NMH, 2 * (pn - 14), row0, wc, fq, rs8); return; }
        if (pn < 14) {
            const int hh = wc >> 1, gp = (4 * wc + fq) & 7;
#pragma unroll
            for (int ai = 0; ai < 2; ++ai)
#pragma unroll
                for (int m = 0; m < 4; ++m) {
                    const int row = row0 + ai * HALF + m * 16;
                    const f32x4 c0 = *(const f32x4*)(COS + (size_t)row * 64 + 8 * gp), c1 = *(const f32x4*)(COS + (size_t)row * 64 + 8 * gp + 4);
                    const f32x4 s0 = *(const f32x4*)(SIN + (size_t)row * 64 + 8 * gp), s1 = *(const f32x4*)(SIN + (size_t)row * 64 + 8 * gp + 4);
                    const f32x4 c = {c0[0], c0[2], c1[0], c1[2]}, s = {s0[0], s0[2], s1[0], s1[2]};
                    const float rs = rs8[ai][m];
#pragma unroll
                    for (int bj = 0; bj < 2; ++bj) {
                        const int ih = ((pn - 10) * 2 + bj) * 2 + hh;
                        const f32x4 x1 = acc[ai][bj][m][0] * rs, x2 = acc[ai][bj][m][1] * rs;
                        const f32x4 y1 = x1 * c - x2 * s, y2 = x1 * s + x2 * c;
                        *(u32x4*)(QI + ((size_t)row * IH + ih) * ID + 8 * gp) = pack8(y1, y2);
                    }
                }
            return;
        }
        if (wc == 0) {
#pragma unroll
            for (int ai = 0; ai < 2; ++ai)
#pragma unroll
                for (int m = 0; m < 4; ++m) {
                    const int row = row0 + ai * HALF + m * 16;
                    const float rsx = rs8[ai][m];
                    float ss = 0.f;
#pragma unroll
                    for (int bj = 0; bj < 2; ++bj)
#pragma unroll
                        for (int n = 0; n < 2; ++n) { const f32x4 x = acc[ai][bj][m][n] * rsx; ss += (x[0] * x[0] + x[1] * x[1]) + (x[2] * x[2] + x[3] * x[3]); }
                    ss += shx(ss, 16, ln); ss += shx(ss, 32, ln);
                    const float rs = rsqrtf(ss * (1.0f / 64.0f) + RMS_EPS);
#pragma unroll
                    for (int n = 0; n < 2; ++n) {
                        const f32x4 ga = *(const f32x4*)(kgain + 8 * fq + 4 * n), gb = *(const f32x4*)(kgain + 32 + 8 * fq + 4 * n);
                        const f32x4 t0 = *(const f32x4*)(COS + (size_t)row * 64 + 16 * fq + 8 * n), t1 = *(const f32x4*)(COS + (size_t)row * 64 + 16 * fq + 8 * n + 4);
                        const f32x4 u0 = *(const f32x4*)(SIN + (size_t)row * 64 + 16 * fq + 8 * n), u1 = *(const f32x4*)(SIN + (size_t)row * 64 + 16 * fq + 8 * n + 4);
                        const f32x4 c = {t0[0], t0[2], t1[0], t1[2]}, s = {u0[0], u0[2], u1[0], u1[2]};
                        const f32x4 a = acc[ai][0][m][n] * (rsx * rs) * ga, b = acc[ai][1][m][n] * (rsx * rs) * gb;
                        const f32x4 y1 = a * c - b * s, y2 = a * s + b * c;
                        *(u32x4*)(KI + ((size_t)((row >> 5) * 4 + fq) * 2 + n) * 256 + (row & 31) * 8) = pack8(y1, y2);
                    }
                    __builtin_amdgcn_sched_barrier(0);
                }
        } else if (wc == 1) {
#pragma unroll
            for (int ai = 0; ai < 2; ++ai)
#pragma unroll
                for (int m = 0; m < 4; ++m) {
                    const int row = row0 + ai * HALF + m * 16;
                    const float rsx = rs8[ai][m];
                    if (fq < 2) {
#pragma unroll
                        for (int n = 0; n < 2; ++n) *(f32x4*)(WI + (size_t)row * IH + 8 * fq + 4 * n) = acc[ai][0][m][n] * (IDX_W_SCALE * rsx);
                    }
                }
        }
    }
};

enum { CT_ID = 0, CT_GU = 1, CT_WINA = 2, CT_WINB = 3, CT_WKV = 4 };
DI int conv_srccol(int type, int np) {
    const int tile = np >> 8, bj = (np >> 7) & 1, p = np & 127;
    switch (type) {
    case CT_ID: return np;
    case CT_GU: return bj * FF + tile * 128 + p;
    case CT_WINA:
        if (tile < 6) return (2 * tile + bj) * HD + rope128_src(p);
        if (tile < 8) return 1536 + (2 * (tile - 6) + bj) * HD + rope128_src(p);
        if (tile < 10) return 2048 + (2 * (tile - 8) + bj) * HD + p;
        if (tile < 14) return 2560 + ((((tile - 10) * 2 + bj) * 2) + (p >> 6)) * ID + rope64_src(p & 63);
        if (tile < 16) return 3664 + (2 * (tile - 14) + bj) * HD + p;
        if (bj == 0) return p < 32 ? 3584 + p : (p < 48 ? 3648 + (p - 32) : -1);
        return p < 32 ? 3584 + 32 + p : -1;
    case CT_WINB:
        if (tile < 6) return (2 * tile + bj) * HD + rope128_src(p);
        return 1536 + (2 * (tile - 6) + bj) * HD + p;
    default:
        if (tile < 2) return (2 * tile + bj) * HD + rope128_src(p);
        return 512 + (2 * (tile - 2) + bj) * HD + p;
    }
}
struct ConvJob { const float* src; const float* gain; unsigned char* dst; int ld, K, type, fp8, n0, k0; };
#ifndef CONV_WIDE
#define CONV_WIDE 2
#endif
#if CONV_WIDE == 1
DI void conv_job_tile(ConvJob& j, int tl, int nnt64) { const int nnt = nnt64 >> 2; j.n0 = (tl % nnt) * 256; j.k0 = (tl / nnt) * 64; }
#else
DI void conv_job_tile(ConvJob& j, int tl, int nnt) { j.n0 = (tl % nnt) * 64; j.k0 = (tl / nnt) * 256; }
#endif
DI void conv_load(const ConvJob& j, f32x4 (&v)[8], f32x4 (&g)[2], int kg, int nq, float zf) {
    const int sc = conv_srccol(j.type, j.n0 + 4 * nq), k0 = j.k0 + 8 * kg;
#pragma unroll
    for (int r = 0; r < 8; ++r) v[r] = sc >= 0 ? *(const f32x4*)(j.src + (size_t)(k0 + r) * j.ld + sc) : (f32x4){zf, zf, zf, zf};
    if (j.gain) { g[0] = *(const f32x4*)(j.gain + k0); g[1] = *(const f32x4*)(j.gain + k0 + 4); } else { g[0] = (f32x4){zf, zf, zf, zf}; g[1] = g[0]; }
}
DI void conv_store(const ConvJob& j, f32x4 (&v)[8], f32x4 (&g)[2], int kg, int nq) {
    const int k0 = j.k0 + 8 * kg, n = j.n0 + 4 * nq;
    if (j.gain) {
        const float sc = j.fp8 ? W8_SCALE : 1.0f;
#pragma unroll
        for (int r = 0; r < 8; ++r) v[r] = v[r] * (g[r >> 2][r & 3] * sc);
    } else if (j.fp8) {
#pragma unroll
        for (int r = 0; r < 8; ++r) v[r] = v[r] * W8_SCALE;
    }
#pragma unroll
    for (int e = 0; e < 4; ++e) {
        const f32x4 a = {v[0][e], v[1][e], v[2][e], v[3][e]}, b = {v[4][e], v[5][e], v[6][e], v[7][e]};
        if (j.fp8) *(u32x2*)(j.dst + (size_t)(n + e) * j.K + k0) = pack8_fp8(a, b);
        else *(u32x4*)((bf16_t*)j.dst + (size_t)(n + e) * j.K + k0) = pack8(a, b);
    }
}

DI void memkv_unit(int unit, const float* mem, const float* gain_all, const float* W_all, bf16_t* MEMK, bf16_t* MEMVT, LAS float* hn, int tid) {
    const int L = unit >> 7, m0 = ((unit >> 2) & 31) * 8, cg = unit & 3, wave = tid >> 6, lane = tid & 63;
    {
        const f32x4* xp = (const f32x4*)(mem + (size_t)(m0 + wave) * D); const f32x4* gp = (const f32x4*)(gain_all + (size_t)L * D);
        f32x4 v[8]; float ss = 0.f;
#pragma unroll
        for (int i = 0; i < 8; ++i) { v[i] = xp[lane + 64 * i]; ss += (v[i][0] * v[i][0] + v[i][1] * v[i][1]) + (v[i][2] * v[i][2] + v[i][3] * v[i][3]); }
        ss = wave_sum(ss, lane); const float rs = rsqrtf(ss * (1.0f / D) + RMS_EPS);
#pragma unroll
        for (int i = 0; i < 8; ++i) { const f32x4 y = v[i] * rs * gp[lane + 64 * i]; *(LAS f32x4*)(hn + wave * D + 4 * (lane + 64 * i)) = y; }
    }
    __syncthreads();
    const int kg = wave, cq = lane;
    const float* W = W_all + (size_t)L * D * KVW + (size_t)kg * (D / 8) * KVW + cg * 256 + 4 * cq;
    LAS const float* hk = hn + kg * (D / 8);
    f32x4 a4[8];
#pragma unroll
    for (int r = 0; r < 8; ++r) a4[r] = (f32x4){0.f, 0.f, 0.f, 0.f};
#pragma unroll 8
    for (int k = 0; k < D / 8; ++k) {
        const f32x4 w4 = *(const f32x4*)(W + (size_t)k * KVW);
#pragma unroll
        for (int r = 0; r < 8; ++r) { const float hv = hk[r * D + k]; a4[r] += hv * w4; }
    }
    LAS float* red = hn + 8 * D;
#pragma unroll
    for (int r = 0; r < 8; ++r) *(LAS f32x4*)(red + (kg * 8 + r) * 256 + 4 * cq) = a4[r];
    __syncthreads();
    {
        const int r = tid >> 6, c0 = 4 * (tid & 63);
        f32x4 v = *(LAS const f32x4*)(red + r * 256 + c0);
#pragma unroll
        for (int g8 = 1; g8 < 8; ++g8) v += *(LAS const f32x4*)(red + (g8 * 8 + r) * 256 + c0);
        const int m = m0 + r;
#pragma unroll
        for (int e = 0; e < 4; ++e) {
            const int col = cg * 256 + c0 + e, isv = col >> 9, hm = (col >> 7) & 3, d = col & 127;
            bf16_t* dst = (isv ? MEMVT : MEMK) + (size_t)(L * NMH + hm) * NMEM * HD;
            dst[isv ? vtblk_off(m, d) : kblk_off(m, d)] = (bf16_t)(pk_bf16(v[e], 0.f) & 0xffffu);
        }
    }
    __syncthreads();
}

DI void xcopy_rows(const float* X, bf16_t* XB, unsigned char* XB8, float* SSo, int gw, int W, int lane) {
    for (int row = gw; row < S; row += W) {
        const f32x4* xp = (const f32x4*)(X + (size_t)row * D);
        f32x4 v[8]; float ss = 0.f;
#pragma unroll
        for (int i = 0; i < 8; ++i) { v[i] = xp[lane + 64 * i]; ss += (v[i][0] * v[i][0] + v[i][1] * v[i][1]) + (v[i][2] * v[i][2] + v[i][3] * v[i][3]); }
        ss = wave_sum(ss, lane);
#pragma unroll
        for (int i = 0; i < 8; ++i) { u32x2 w; w.x = pk_bf16(v[i][0], v[i][1]); w.y = pk_bf16(v[i][2], v[i][3]); *(u32x2*)(XB + (size_t)row * D + 4 * (lane + 64 * i)) = w;
            if (XB8) { int b8 = 0; b8 = __builtin_amdgcn_cvt_pk_fp8_f32(v[i][0], v[i][1], b8, false); b8 = __builtin_amdgcn_cvt_pk_fp8_f32(v[i][2], v[i][3], b8, true); *(int*)(XB8 + (size_t)row * D + 4 * (lane + 64 * i)) = b8; } }
        if (lane < 32) SSo[(size_t)row * 32 + lane] = lane == 0 ? ss : 0.f;
    }
}
DI void final_norm_rows(const bf16_t* XB, float* Xout, const float* g, const float* SS, int gw, int W, int lane) {
    for (int row = gw; row < S; row += W) {
        const u32x4* xp = (const u32x4*)(XB + (size_t)row * D); f32x4* op = (f32x4*)(Xout + (size_t)row * D);
        const float rs = rsqrtf(wave_sum(lane < 32 ? SS[(size_t)row * 32 + lane] : 0.f, lane) * (1.0f / D) + RMS_EPS);
#pragma unroll
        for (int i = 0; i < 4; ++i) {
            const u32x4 x = xp[lane + 64 * i]; const f32x4 g0 = ((const f32x4*)g)[2 * (lane + 64 * i)], g1 = ((const f32x4*)g)[2 * (lane + 64 * i) + 1];
            const f32x4 x0 = {bf_lo(x.x), bf_hi(x.x), bf_lo(x.y), bf_hi(x.y)}, x1 = {bf_lo(x.z), bf_hi(x.z), bf_lo(x.w), bf_hi(x.w)};
            op[2 * (lane + 64 * i)] = x0 * rs * g0; op[2 * (lane + 64 * i) + 1] = x1 * rs * g1;
        }
    }
}

DI void kvpost_unit(int unit, const bf16_t* Kb, const bf16_t* Vb, float* KMEAN, bf16_t* KBLK, bf16_t* VTBLK, LAS unsigned char* lds, int tid) {
    const int g = unit & 3, n = unit >> 2;
    LAS unsigned short* lk = (LAS unsigned short*)lds;
    LAS unsigned short* lv = (LAS unsigned short*)(lds + 65536);
    LAS float* part = (LAS float*)(lds + STAGE_LDS + 1024);
#pragma unroll
    for (int i = 0; i < 8; ++i) {
        const int item = tid + 512 * i, key = item >> 4, c = item & 15;
        const size_t src = ((size_t)(n * MBLK + key) * NKV + g) * HD + 8 * c;
        *(LAS u32x4*)(lk + key * HD + 8 * c) = *(const u32x4*)(Kb + src);
        *(LAS u32x4*)(lv + key * HD + 8 * c) = *(const u32x4*)(Vb + src);
    }
    __syncthreads();
    {
        const int d = tid & 127, part_id = tid >> 7; float s = 0.f;
        for (int k = 0; k < 64; ++k) s += bf_lo((unsigned)lk[(part_id * 64 + k) * HD + d]);
        part[part_id * 128 + d] = s;
    }
    const size_t bb = (size_t)(g * NBLK + n) * MBLK * HD;
#pragma unroll
    for (int i = 0; i < 8; ++i) {
        const int item = tid + 512 * i, ln = item & 63, ks = (item >> 6) & 7, mt = item >> 9, r = ln & 31, h = ln >> 5;
        *(u32x4*)(KBLK + bb + (size_t)item * 8) = *(const LAS u32x4*)(lk + (32 * mt + r) * HD + 16 * ks + 8 * h);
    }
#pragma unroll
    for (int i = 0; i < 8; ++i) {
        const int item = tid + 512 * i, ln = item & 63, s2 = (item >> 6) & 1, mt = (item >> 7) & 7, dt = item >> 10, r = ln & 31, h = ln >> 5;
        unsigned short e[8];
#pragma unroll
        for (int j = 0; j < 8; ++j) e[j] = lv[vt_pos(32 * mt + 16 * s2 + 8 * h + j) * HD + 32 * dt + r];
        u32x4 w; w.x = e[0] | ((unsigned)e[1] << 16); w.y = e[2] | ((unsigned)e[3] << 16); w.z = e[4] | ((unsigned)e[5] << 16); w.w = e[6] | ((unsigned)e[7] << 16);
        *(u32x4*)(VTBLK + bb + (size_t)item * 8) = w;
    }
    __syncthreads();
    if (tid < 128) KMEAN[(size_t)(g * NBLK + n) * HD + tid] = (part[tid] + part[128 + tid] + part[256 + tid] + part[384 + tid]) * (1.0f / MBLK);
    __syncthreads();
}
#define MFMA32(a, b, c) __builtin_amdgcn_mfma_f32_32x32x16_bf16((a), (b), (c), 0, 0, 0)
#define MFMA16(a, b, c) __builtin_amdgcn_mfma_f32_16x16x32_bf16((a), (b), (c), 0, 0, 0)
typedef unsigned v4u32 __attribute__((ext_vector_type(4)));
DI const bf16_t* uni_ptr(const bf16_t* p) { const unsigned long long v = (unsigned long long)p; const unsigned lo = __builtin_amdgcn_readfirstlane((unsigned)v), hi = __builtin_amdgcn_readfirstlane((unsigned)(v >> 32)); return (const bf16_t*)(((unsigned long long)hi << 32) | lo); }
DI bf16x8 bload(__amdgpu_buffer_rsrc_t rs, unsigned voff, unsigned soff) { return __builtin_bit_cast(bf16x8, __builtin_amdgcn_raw_buffer_load_b128(rs, voff, soff, 0)); }
constexpr int LCAP = 640;
DI float vmax3(float a, float b, float c) { float r; asm volatile("v_max3_f32 %0, %1, %2, %3" : "=v"(r) : "v"(a), "v"(b), "v"(c)); return r; }
DI unsigned fkey(float f) { const unsigned u = __float_as_uint(f); return u ^ ((unsigned)((int)u >> 31) | 0x80000000u); }
DI float funkey(unsigned k) { return __uint_as_float((k & 0x80000000u) ? (k ^ 0x80000000u) : ~k); }
DI int lane_prefix(unsigned long long m) { return (int)__builtin_amdgcn_mbcnt_hi((unsigned)(m >> 32), __builtin_amdgcn_mbcnt_lo((unsigned)m, 0u)); }

constexpr int SEL_NE = LCAP / 64, SEL_SLACK = 64;
template <bool EXACT> DI int select256(LAS float* lv, LAS unsigned short* li, int cnt, int lane, float& tau) {
    lds_fence();
    unsigned ku[SEL_NE]; unsigned id[SEL_NE];
    unsigned kmin = 0xffffffffu, kmax = 0u;
#pragma unroll
    for (int e = 0; e < SEL_NE; ++e) {
        const int idx = e * 64 + lane; const bool in = idx < cnt;
        const float v = lv[in ? idx : 0]; id[e] = li[in ? idx : 0];
        ku[e] = in ? fkey(v) : 0u;
        kmin = in ? (ku[e] < kmin ? ku[e] : kmin) : kmin; kmax = ku[e] > kmax ? ku[e] : kmax;
    }
#pragma unroll
    for (int o = 32; o >= 1; o >>= 1) { const unsigned a = shxu(kmin, o, lane), b = shxu(kmax, o, lane); kmin = a < kmin ? a : kmin; kmax = b > kmax ? b : kmax; }
    unsigned lo = __builtin_amdgcn_readfirstlane(kmin), hi = __builtin_amdgcn_readfirstlane(kmax) + 1u;
    while (hi - lo > 1u) {
        const unsigned mid = lo + ((hi - lo) >> 1);
        int c = 0;
#pragma unroll
        for (int e = 0; e < SEL_NE; ++e) c += __popcll(__ballot(ku[e] >= mid));
        if (c >= TOPK) lo = mid; else hi = mid;
        if (EXACT ? (c == TOPK) : (c >= TOPK && c <= TOPK + SEL_SLACK)) break;
    }
    const unsigned tk = lo;
    int need = LCAP;
    if (EXACT) {
        int ngt = 0;
#pragma unroll
        for (int e = 0; e < SEL_NE; ++e) ngt += __popcll(__ballot(ku[e] > tk));
        need = TOPK - ngt;
    }
    int base = 0, eqbase = 0;
    lds_fence();
#pragma unroll
    for (int e = 0; e < SEL_NE; ++e) {
        const bool eq = ku[e] == tk; const unsigned long long meq = __ballot(eq);
        const int eqrank = eqbase + lane_prefix(meq);
        const bool keep = (ku[e] > tk) || (eq && eqrank < need);
        const unsigned long long mk = __ballot(keep);
        const int pos = base + lane_prefix(mk);
        if (keep) { lv[pos] = funkey(ku[e]); li[pos] = (unsigned short)id[e]; }
        base += __popcll(mk); eqbase += __popcll(meq);
    }
    lds_fence();
    tau = funkey(tk);
    return base;
}

DI f32x16 idx_fake_mm(bf16x8 a, bf16x8 b, f32x16 c) { asm volatile("" : "+v"(c) : "v"(a), "v"(b)); return c; }
template <int PROBE_MODE = 0> DI void idx_phase(const bf16_t* QI, const bf16_t* KI, const float* WI, unsigned short* SEL, int* NSEL, LAS unsigned char* lds, int tid, int bid, int G,
                                                int gw_ov = -1, int W_ov = 0, LAS unsigned char* lwave = nullptr, volatile LAS int* flag = nullptr) {
    const int lane = tid & 63, wave = __builtin_amdgcn_readfirstlane(tid >> 6), gw = gw_ov >= 0 ? gw_ov : bid * NWAVES + wave, W = gw_ov >= 0 ? W_ov : G * NWAVES;
    LAS unsigned char* lw = gw_ov >= 0 ? lwave : lds + wave * (LCAP * 24);
    LAS float* LV = (LAS float*)lw; LAS unsigned short* LI = (LAS unsigned short*)(lw + LCAP * 16);
    int done = 0;
    const int h = lane >> 5, r = lane & 31;
    constexpr int NU = S / 4;
    const __amdgpu_buffer_rsrc_t rsKI = __builtin_amdgcn_make_buffer_rsrc((void*)uni_ptr(KI), (short)0, S * ID * 2, 0x00020000);
    for (int i0 = gw; i0 < NU / 2; i0 += W)
        for (int rep = 0; rep < 2; ++rep) {
            const int u = rep ? (NU - 1 - i0) : i0, t0 = 4 * u;
            bf16x8 af[2][4]; float wv[2][16];
#pragma unroll
            for (int p = 0; p < 2; ++p) {
                const int qsel = (r >> 2) & 1, hd = (r & 3) + 4 * (r >> 3);
                const bf16_t* qp = QI + ((size_t)(t0 + 2 * p + qsel) * IH + hd) * ID + 8 * h;
#pragma unroll
                for (int ks = 0; ks < 4; ++ks) af[p][ks] = *(const bf16x8*)(qp + 16 * ks);
                const f32x4* wp = (const f32x4*)(WI + (size_t)(t0 + 2 * p + h) * IH);
#pragma unroll
                for (int j = 0; j < 4; ++j) { const f32x4 w4 = wp[j]; wv[p][4 * j] = w4[0]; wv[p][4 * j + 1] = w4[1]; wv[p][4 * j + 2] = w4[2]; wv[p][4 * j + 3] = w4[3]; }
            }
            int cnt[4] = {0, 0, 0, 0}; float tau[4];
#pragma unroll
            for (int q = 0; q < 4; ++q) tau[q] = -__builtin_inff();
            float taul[2] = {-__builtin_inff(), -__builtin_inff()};
            const int ntile = (t0 + 3) / 32 + 1;
            bf16x8 ring[4][4];
#define IDX_LOAD(slot, tile) do { if (PROBE_MODE == 3 && (tile) > 2) break; const unsigned so_ = (unsigned)((tile) < ntile ? (tile) : ntile - 1) * 4096u; \
        _Pragma("unroll") for (int ks = 0; ks < 4; ++ks) ring[slot][ks] = bload(rsKI, (unsigned)lane * 16u, so_ + 1024u * ks); } while (0)
            IDX_LOAD(0, 0); IDX_LOAD(1, 1); IDX_LOAD(2, 2);
#define IDX_CHUNK0(acc, p, sc) do { if (PROBE_MODE == 4) { asm volatile("" :: "v"(acc[0]), "v"(acc[15])); break; } float y0_, y1_, y2_, y3_; \
        asm volatile("s_nop 11\n\tv_max_i32 %0, 0, %4\n\tv_max_i32 %1, 0, %5\n\tv_max_i32 %2, 0, %6\n\tv_max_i32 %3, 0, %7" : "=&v"(y0_), "=&v"(y1_), "=&v"(y2_), "=&v"(y3_) : "v"(acc[0]), "v"(acc[1]), "v"(acc[2]), "v"(acc[3])); \
        sc = fmaf(wv[p][0], y0_, sc); sc = fmaf(wv[p][1], y1_, sc); sc = fmaf(wv[p][2], y2_, sc); sc = fmaf(wv[p][3], y3_, sc); } while (0)
#define IDX_CHUNKN(acc, p, c, sc) do { if (PROBE_MODE == 4) break; float y0_, y1_, y2_, y3_; \
        asm volatile("v_max_i32 %0, 0, %4\n\tv_max_i32 %1, 0, %5\n\tv_max_i32 %2, 0, %6\n\tv_max_i32 %3, 0, %7" : "=&v"(y0_), "=&v"(y1_), "=&v"(y2_), "=&v"(y3_) : "v"(acc[4 * (c)]), "v"(acc[4 * (c) + 1]), "v"(acc[4 * (c) + 2]), "v"(acc[4 * (c) + 3])); \
        sc = fmaf(wv[p][4 * (c)], y0_, sc); sc = fmaf(wv[p][4 * (c) + 1], y1_, sc); sc = fmaf(wv[p][4 * (c) + 2], y2_, sc); sc = fmaf(wv[p][4 * (c) + 3], y3_, sc); } while (0)
  \
#define IDX_FILTER(p, ktv, scv) do { if (PROBE_MODE >= 2) { tau[2 * (p)] += (scv) + 0.0f; break; } \
        if (__builtin_amdgcn_ballot_w64((scv) > taul[p]) != 0ull) { \
            const float sc_ = (scv) + 0.0f; const int key_ = 32 * (ktv) + r, tq_ = t0 + 2 * (p) + h; \
            const bool pass_ = (key_ <= tq_) && (sc_ > taul[p]); const unsigned long long mask_ = __builtin_amdgcn_ballot_w64(pass_); \
            if (mask_ != 0ull) { const unsigned mlo_ = (unsigned)mask_, mhi_ = (unsigned)(mask_ >> 32); const unsigned mym_ = h ? mhi_ : mlo_; \
                const int slot_ = (h ? cnt[2 * (p) + 1] : cnt[2 * (p)]) + __popc(mym_ & ((1u << r) - 1u)); \
                if (pass_) { LV[(2 * (p) + h) * LCAP + slot_] = sc_; LI[(2 * (p) + h) * LCAP + slot_] = (unsigned short)key_; } \
                cnt[2 * (p)] = __builtin_amdgcn_readfirstlane(cnt[2 * (p)] + __popc(mlo_)); cnt[2 * (p) + 1] = __builtin_amdgcn_readfirstlane(cnt[2 * (p) + 1] + __popc(mhi_)); } } } while (0)
#define IDX_SB __builtin_amdgcn_sched_barrier(0)
#define IDX_MM(a_, b_, c_) (PROBE_MODE == 5 ? idx_fake_mm((a_), (b_), (c_)) : MFMA32((a_), (b_), (c_)))
            f32x16 zero16;
#pragma unroll
            for (int j = 0; j < 16; ++j) zero16[j] = 0.f;
            f32x16 accA = zero16, accB = zero16;
            for (int kt0 = 0; kt0 < ntile; kt0 += 4)
#pragma unroll
            for (int u4 = 0; u4 < 4; ++u4) {
                const int kt = kt0 + u4;
                if (kt >= ntile) break;
                IDX_LOAD((u4 + 3) & 3, kt + 3);
                bf16x8 bfr[4];
#pragma unroll
                for (int ks = 0; ks < 4; ++ks) bfr[ks] = ring[u4][ks];
                if (kt > 0) {
                    float scB = 0.f;
                    IDX_SB; accA = IDX_MM(af[0][0], bfr[0], zero16); IDX_SB; IDX_CHUNK0(accB, 1, scB);
                    IDX_SB; accA = IDX_MM(af[0][1], bfr[1], accA); IDX_SB; IDX_CHUNKN(accB, 1, 1, scB);
                    IDX_SB; accA = IDX_MM(af[0][2], bfr[2], accA); IDX_SB; IDX_CHUNKN(accB, 1, 2, scB);
                    IDX_SB; accA = IDX_MM(af[0][3], bfr[3], accA); IDX_SB; IDX_CHUNKN(accB, 1, 3, scB);
                    IDX_FILTER(1, kt - 1, scB);
                } else {
                    accA = IDX_MM(af[0][0], bfr[0], zero16); accA = IDX_MM(af[0][1], bfr[1], accA); accA = IDX_MM(af[0][2], bfr[2], accA); accA = IDX_MM(af[0][3], bfr[3], accA);
                }
                {
                    float scA = 0.f;
                    IDX_SB; accB = IDX_MM(af[1][0], bfr[0], zero16); IDX_SB; IDX_CHUNK0(accA, 0, scA);
                    IDX_SB; accB = IDX_MM(af[1][1], bfr[1], accB); IDX_SB; IDX_CHUNKN(accA, 0, 1, scA);
                    IDX_SB; accB = IDX_MM(af[1][2], bfr[2], accB); IDX_SB; IDX_CHUNKN(accA, 0, 2, scA);
                    IDX_SB; accB = IDX_MM(af[1][3], bfr[3], accB); IDX_SB; IDX_CHUNKN(accA, 0, 3, scA);
                    IDX_FILTER(0, kt, scA);
                }
#pragma unroll
                for (int q = 0; q < 4; ++q)
                    if (PROBE_MODE < 2 && cnt[q] > LCAP - 64) {
                        cnt[q] = __builtin_amdgcn_readfirstlane(select256<false>(LV + q * LCAP, LI + q * LCAP, cnt[q], lane, tau[q]));
                        if (cnt[q] > LCAP - 64) cnt[q] = __builtin_amdgcn_readfirstlane(select256<true>(LV + q * LCAP, LI + q * LCAP, cnt[q], lane, tau[q]));
                        if (h == (q & 1)) taul[q >> 1] = tau[q];
                    }
            }
            {
                float scB = 0.f;
                IDX_CHUNK0(accB, 1, scB); IDX_CHUNKN(accB, 1, 1, scB); IDX_CHUNKN(accB, 1, 2, scB); IDX_CHUNKN(accB, 1, 3, scB);
                IDX_FILTER(1, ntile - 1, scB);
            }
#undef IDX_MM
#undef IDX_CHUNK0
#undef IDX_CHUNKN
#undef IDX_FILTER
#undef IDX_SB
#pragma unroll
            for (int q = 0; q < 4; ++q) {
                if (PROBE_MODE >= 2) { if (tau[q] == 12345.f) cnt[q] = 1; } else
                if (cnt[q] > TOPK) { float dummy; cnt[q] = select256<true>(LV + q * LCAP, LI + q * LCAP, cnt[q], lane, dummy); }
                lds_fence();
                const int t = t0 + q;
#pragma unroll
                for (int j = 0; j < 4; ++j) { const int idx = j * 64 + lane; SEL[(size_t)t * TOPK + idx] = idx < cnt[q] ? LI[q * LCAP + idx] : (unsigned short)0; }
                if (lane == 0) NSEL[t] = cnt[q];
            }
            lds_fence();
            if (flag) { __builtin_amdgcn_fence(__ATOMIC_RELEASE, "workgroup"); ++done; if (lane == 0) *flag = done; }
        }
}

DI void attn_item(const bf16_t* qrow, const bf16_t* Kblk_, const bf16_t* Vt_, bool causal, int kbase, int tq, int lane, f32x16 (&oacc)[4], float& mlog, float& lsum) {
    const int h = lane >> 5;
    const __amdgpu_buffer_rsrc_t rsK = __builtin_amdgcn_make_buffer_rsrc((void*)uni_ptr(Kblk_), (short)0, HD * MBLK * 2, 0x00020000);
    const __amdgpu_buffer_rsrc_t rsV = __builtin_amdgcn_make_buffer_rsrc((void*)uni_ptr(Vt_), (short)0, HD * MBLK * 2, 0x00020000);
    const unsigned voff = (unsigned)lane * 16u;
    constexpr int RD = 12;
    bf16x8 ring[RD];
#pragma unroll
    for (int f = 0; f < RD - 1; ++f) ring[f] = bload(rsK, voff, (unsigned)(f * 1024));
    bf16x8 qf[8];
#pragma unroll
    for (int ks = 0; ks < 8; ++ks) qf[ks] = *(const bf16x8*)(qrow + 16 * ks + 8 * h);
    f32x16 sacc[8];
#pragma unroll
    for (int mt = 0; mt < 8; ++mt) {
#pragma unroll
        for (int j = 0; j < 16; ++j) sacc[mt][j] = 0.f;
#pragma unroll
        for (int ks = 0; ks < 8; ++ks) {
            const int f = mt * 8 + ks;
            if (f + RD - 1 < 64) ring[(f + RD - 1) % RD] = bload(rsK, voff, (unsigned)((f + RD - 1) * 1024));
            sacc[mt] = MFMA32(ring[f % RD], qf[ks], sacc[mt]);
            if ((ks & 3) == 3) __builtin_amdgcn_sched_barrier(0);
        }
    }
#define VT_FRAG(u) ((unsigned)((((((u) & 3) * 8 + ((u) >> 3)) * 2) + (((u) >> 2) & 1)) * 1024))
#pragma unroll
    for (int u = 0; u < RD - 1; ++u) ring[u] = bload(rsV, voff, VT_FRAG(u));
    __builtin_amdgcn_sched_barrier(0);
    float mx = -__builtin_inff();
#pragma unroll
    for (int mt = 0; mt < 8; ++mt)
#pragma unroll
        for (int j = 0; j < 16; ++j) {
            const int key = 32 * mt + (j & 3) + 8 * (j >> 2) + 4 * h;
            float s = sacc[mt][j];
            if (causal && (kbase + key > tq)) s = -__builtin_inff();
            sacc[mt][j] = s; mx = fmaxf(mx, s);
        }
    mx = fmaxf(mx, shx(mx, 32, lane));
    mlog = mx * ATT_SC;
    float l = 0.f;
    u32x4 pw[8][2];
#pragma unroll
    for (int mt = 0; mt < 8; ++mt)
#pragma unroll
        for (int s2 = 0; s2 < 2; ++s2) {
            float p[8];
#pragma unroll
            for (int j = 0; j < 8; ++j) { p[j] = __builtin_amdgcn_exp2f(sacc[mt][8 * s2 + j] * ATT_SC - mlog); l += p[j]; }
            pw[mt][s2].x = pk_bf16(p[0], p[1]); pw[mt][s2].y = pk_bf16(p[2], p[3]); pw[mt][s2].z = pk_bf16(p[4], p[5]); pw[mt][s2].w = pk_bf16(p[6], p[7]);
        }
    l += shx(l, 32, lane);
    lsum = l;
#pragma unroll
    for (int dt = 0; dt < 4; ++dt)
#pragma unroll
        for (int j = 0; j < 16; ++j) oacc[dt][j] = 0.f;
    __builtin_amdgcn_sched_barrier(0);
#pragma unroll
    for (int mt = 0; mt < 8; ++mt)
#pragma unroll
        for (int s2 = 0; s2 < 2; ++s2) {
            const bf16x8 pb = __builtin_bit_cast(bf16x8, pw[mt][s2]);
#pragma unroll
            for (int dt = 0; dt < 4; ++dt) {
                const int u = (mt * 2 + s2) * 4 + dt;
                if (u + RD - 1 < 64) ring[(u + RD - 1) % RD] = bload(rsV, voff, VT_FRAG(u + RD - 1));
                oacc[dt] = MFMA32(ring[u % RD], pb, oacc[dt]);
            }
            __builtin_amdgcn_sched_barrier(0);
        }
#undef VT_FRAG
}

DI void memattn_item(int item, int L, const bf16_t* QM, const bf16_t* MEMK, const bf16_t* MEMVT, bf16_t* AO, int lane) {
    const int hm = item & 3, t = (item >> 2) * 32 + (lane & 31), h = lane >> 5;
    f32x16 oacc[4]; float mlog, l;
    attn_item(QM + ((size_t)t * NMH + hm) * HD, MEMK + (size_t)(L * NMH + hm) * NMEM * HD, MEMVT + (size_t)(L * NMH + hm) * HD * NMEM, false, 0, 0, lane, oacc, mlog, l);
    const float inv = 1.0f / l;
    bf16_t* op = AO + (size_t)t * D + NH * HD + hm * HD;
#pragma unroll
    for (int dt = 0; dt < 4; ++dt)
#pragma unroll
        for (int q4 = 0; q4 < 4; ++q4) {
            u32x2 w; w.x = pk_bf16(oacc[dt][4 * q4] * inv, oacc[dt][4 * q4 + 1] * inv); w.y = pk_bf16(oacc[dt][4 * q4 + 2] * inv, oacc[dt][4 * q4 + 3] * inv);
            *(u32x2*)(op + 32 * dt + 8 * q4 + 4 * h) = w;
        }
}

#define MFMA16F8(a, b, c) __builtin_amdgcn_mfma_f32_16x16x32_fp8_fp8((a), (b), (c), 0, 0, 0)
DI long mk_i64(unsigned lo, unsigned hi) { return (long)(((unsigned long long)hi << 32) | lo); }
DI void dsa_query(int t, int g0, int g1, const bf16_t* Q, const unsigned char* K8, const unsigned char* V8, const unsigned short* SEL, const int* NSEL, bf16_t* AO, LAS unsigned char* wl, int lane) {
    LAS float* Pl = (LAS float*)wl;
    LAS unsigned short* selL = (LAS unsigned short*)(wl + 4096);
    LAS float* linv = (LAS float*)(wl + 4096 + 512);
    const int ns = NSEL[t];
    {
        const u32x2 sv = *(const u32x2*)(SEL + (size_t)t * TOPK + 4 * lane);
        *(LAS u32x2*)(selL + 4 * lane) = sv;
    }
    lds_fence();
    const int c = lane & 15, kq = lane >> 4;
    const __amdgpu_buffer_rsrc_t rsK = __builtin_amdgcn_make_buffer_rsrc((void*)uni_ptr((const bf16_t*)K8), (short)0, S * NKV * HD, 0x00020000);
    const __amdgpu_buffer_rsrc_t rsV = __builtin_amdgcn_make_buffer_rsrc((void*)uni_ptr((const bf16_t*)V8), (short)0, S * NKV * HD, 0x00020000);
    long qf[4];
#pragma unroll
    for (int u = 0; u < 2; ++u) {
        unsigned zu = 0u; asm volatile("" : "+v"(zu));
        u32x4 q0 = {zu, zu, zu, zu}, q1 = {zu, zu, zu, zu};
        if (c < NH) { const u32x4* qp = (const u32x4*)(Q + ((size_t)t * NH + c) * HD + 64 * u + 16 * kq); q0 = qp[0]; q1 = qp[1]; }
        const u32x2 f0 = pack8_fp8((f32x4){bf_lo(q0.x), bf_hi(q0.x), bf_lo(q0.y), bf_hi(q0.y)}, (f32x4){bf_lo(q0.z), bf_hi(q0.z), bf_lo(q0.w), bf_hi(q0.w)});
        const u32x2 f1 = pack8_fp8((f32x4){bf_lo(q1.x), bf_hi(q1.x), bf_lo(q1.y), bf_hi(q1.y)}, (f32x4){bf_lo(q1.z), bf_hi(q1.z), bf_lo(q1.w), bf_hi(q1.w)});
        qf[2 * u] = mk_i64(f0.x, f0.y); qf[2 * u + 1] = mk_i64(f1.x, f1.y);
    }
    for (int g = g0; g < g1; ++g) {
        const unsigned gofs = (unsigned)g * HD;
        constexpr int KR = 8;
        u32x4 kr[KR][2];
#define DSA_KLOAD(slot, j) do { const unsigned vo_ = (unsigned)selL[16 * (j) + c] * (NKV * HD) + gofs + 16u * kq; \
        kr[slot][0] = __builtin_bit_cast(u32x4, bload(rsK, vo_, 0u)); kr[slot][1] = __builtin_bit_cast(u32x4, bload(rsK, vo_, 64u)); } while (0)
#pragma unroll
        for (int j = 0; j < KR - 1; ++j) DSA_KLOAD(j, j);
        f32x4 sacc[16];
#pragma unroll
        for (int j = 0; j < 16; ++j) {
            if (j + KR - 1 < 16) DSA_KLOAD((j + KR - 1) % KR, j + KR - 1);
            f32x4 a4 = {0.f, 0.f, 0.f, 0.f};
#pragma unroll
            for (int u = 0; u < 2; ++u) {
                const u32x4 kv = kr[j % KR][u];
                a4 = MFMA16F8(mk_i64(kv.x, kv.y), qf[2 * u], a4);
                a4 = MFMA16F8(mk_i64(kv.z, kv.w), qf[2 * u + 1], a4);
            }
            sacc[j] = a4;
        }
#undef DSA_KLOAD
        constexpr int VR = 24;
        u32x2 vr[VR];
#define DSA_VLOAD(slot, i) do { const unsigned vo_ = (unsigned)selL[4 * (i) + kq] * (NKV * HD) + gofs + 8u * c; vr[slot] = __builtin_bit_cast(u32x2, __builtin_amdgcn_raw_buffer_load_b64(rsV, vo_, 0u, 0)); } while (0)
#pragma unroll
        for (int i = 0; i < VR - 1; ++i) DSA_VLOAD(i, i);
        float mx = -__builtin_inff();
#pragma unroll
        for (int j = 0; j < 16; ++j)
#pragma unroll
            for (int e = 0; e < 4; ++e) { const int slot = 16 * j + 4 * kq + e; const float s = slot < ns ? sacc[j][e] : -__builtin_inff(); sacc[j][e] = s; mx = fmaxf(mx, s); }
        mx = fmaxf(mx, shx(mx, 16, lane)); mx = fmaxf(mx, shx(mx, 32, lane));
        const float ml = mx * ATT_SC; float l = 0.f;
#pragma unroll
        for (int j = 0; j < 16; ++j)
#pragma unroll
            for (int e = 0; e < 4; ++e) { const float p = __builtin_amdgcn_exp2f(sacc[j][e] * ATT_SC - ml); sacc[j][e] = p; l += p; }
        l += shx(l, 16, lane); l += shx(l, 32, lane);
        const int rr = c - 3 * g;
        if (rr >= 0 && rr < 3) {
#pragma unroll
            for (int j = 0; j < 16; ++j)
#pragma unroll
                for (int e = 0; e < 4; ++e) Pl[(16 * j + 4 * kq + e) * 4 + rr] = sacc[j][e];
            if (kq == 0) linv[rr] = 1.0f / l;
        }
        lds_fence();
        f32x2 o2[3][4];
#pragma unroll
        for (int a = 0; a < 3; ++a)
#pragma unroll
            for (int e = 0; e < 4; ++e) o2[a][e] = (f32x2){0.f, 0.f};
        for (int i0 = 0; i0 < 64; i0 += VR) {
#pragma unroll
            for (int u = 0; u < VR; ++u) {
                const int i = i0 + u;
                if (i < 64) {
                    if (i + VR - 1 < 64) DSA_VLOAD((u + VR - 1) % VR, i + VR - 1);
                    const u32x2 v = vr[u];
                    const f32x4 p = *(const LAS f32x4*)(Pl + (4 * i + kq) * 4);
                    const f32x2 v01 = __builtin_amdgcn_cvt_pk_f32_fp8((int)v.x, false), v23 = __builtin_amdgcn_cvt_pk_f32_fp8((int)v.x, true);
                    const f32x2 v45 = __builtin_amdgcn_cvt_pk_f32_fp8((int)v.y, false), v67 = __builtin_amdgcn_cvt_pk_f32_fp8((int)v.y, true);
#pragma unroll
                    for (int a = 0; a < 3; ++a) {
                        const f32x2 pp = {p[a], p[a]};
                        o2[a][0] = __builtin_elementwise_fma(pp, v01, o2[a][0]); o2[a][1] = __builtin_elementwise_fma(pp, v23, o2[a][1]);
                        o2[a][2] = __builtin_elementwise_fma(pp, v45, o2[a][2]); o2[a][3] = __builtin_elementwise_fma(pp, v67, o2[a][3]);
                    }
                }
            }
        }
#undef DSA_VLOAD
        float o[3][8];
#pragma unroll
        for (int a = 0; a < 3; ++a)
#pragma unroll
            for (int e = 0; e < 8; ++e) { float x = o2[a][e >> 1][e & 1]; x += shx(x, 16, lane); x += shx(x, 32, lane); o[a][e] = x; }
        if (kq == 0) {
#pragma unroll
            for (int a = 0; a < 3; ++a) {
                const float iv = linv[a];
                u32x4 w; w.x = pk_bf16(o[a][0] * iv, o[a][1] * iv); w.y = pk_bf16(o[a][2] * iv, o[a][3] * iv); w.z = pk_bf16(o[a][4] * iv, o[a][5] * iv); w.w = pk_bf16(o[a][6] * iv, o[a][7] * iv);
                *(u32x4*)(AO + (size_t)t * D + (3 * g + a) * HD + 8 * c) = w;
            }
        }
        lds_fence();
    }
}

#ifndef DSA_MFMA
#define DSA_MFMA 1
#endif
#define DSA_TR8(r0, r1, r2, r3, r4, r5, r6, r7, a0, a1, a2, a3, OFS) asm volatile( \
    "ds_read_b64_tr_b16 %0, %8 offset:%12\n\tds_read_b64_tr_b16 %1, %8 offset:%12+2048\n\tds_read_b64_tr_b16 %2, %9 offset:%12\n\tds_read_b64_tr_b16 %3, %9 offset:%12+2048\n\t" \
    "ds_read_b64_tr_b16 %4, %10 offset:%12\n\tds_read_b64_tr_b16 %5, %10 offset:%12+2048\n\tds_read_b64_tr_b16 %6, %11 offset:%12\n\tds_read_b64_tr_b16 %7, %11 offset:%12+2048\n\ts_waitcnt lgkmcnt(0)" \
    : "=&v"(r0), "=&v"(r1), "=&v"(r2), "=&v"(r3), "=&v"(r4), "=&v"(r5), "=&v"(r6), "=&v"(r7) : "v"(a0), "v"(a1), "v"(a2), "v"(a3), "n"(OFS) : "memory")
DI void dsa_query2(int t, int g0, int g1, const bf16_t* Q, const unsigned char* K8, const unsigned char* V8, const unsigned short* SEL, const int* NSEL, bf16_t* AO, LAS unsigned char* vb, LAS unsigned char* sl, int lane) {
    LAS unsigned short* selL = (LAS unsigned short*)sl;
    const int ns = NSEL[t];
    {
        const u32x2 sv = *(const u32x2*)(SEL + (size_t)t * TOPK + 4 * lane);
        *(LAS u32x2*)(selL + 4 * lane) = sv;
    }
    lds_fence();
    const int c = lane & 15, kq = lane >> 4;
    const __amdgpu_buffer_rsrc_t rsK = __builtin_amdgcn_make_buffer_rsrc((void*)uni_ptr((const bf16_t*)K8), (short)0, S * NKV * HD, 0x00020000);
    long qf[4];
#pragma unroll
    for (int u = 0; u < 2; ++u) {
        unsigned zu = 0u; asm volatile("" : "+v"(zu));
        u32x4 q0 = {zu, zu, zu, zu}, q1 = {zu, zu, zu, zu};
        if (c < NH) { const u32x4* qp = (const u32x4*)(Q + ((size_t)t * NH + c) * HD + 64 * u + 16 * kq); q0 = qp[0]; q1 = qp[1]; }
        const u32x2 f0 = pack8_fp8((f32x4){bf_lo(q0.x), bf_hi(q0.x), bf_lo(q0.y), bf_hi(q0.y)}, (f32x4){bf_lo(q0.z), bf_hi(q0.z), bf_lo(q0.w), bf_hi(q0.w)});
        const u32x2 f1 = pack8_fp8((f32x4){bf_lo(q1.x), bf_hi(q1.x), bf_lo(q1.y), bf_hi(q1.y)}, (f32x4){bf_lo(q1.z), bf_hi(q1.z), bf_lo(q1.w), bf_hi(q1.w)});
        qf[2 * u] = mk_i64(f0.x, f0.y); qf[2 * u + 1] = mk_i64(f1.x, f1.y);
    }
    unsigned tra[4];
    {
        const int q = (lane >> 2) & 3, p = lane & 3, sw = ((kq & 1) << 1) | (q >> 1);
#pragma unroll
        for (int db = 0; db < 4; ++db) tra[db] = (unsigned)(unsigned long long)vb + (unsigned)((4 * kq + q) * 128 + ((((db ^ sw) << 1) | (p >> 1)) << 4) + 8 * (p & 1));
    }
    const int dch = ((lane & 7) ^ (((lane >> 4) & 3) << 1)) * 16;
#pragma unroll 1
    for (int g = g0; g < g1; ++g) {
        const unsigned gofs = (unsigned)g * HD;
#define DSA_VDMA(kb) do { const unsigned key_ = (unsigned)selL[8 * (kb) + (lane >> 3)];     \
        __builtin_amdgcn_global_load_lds((const unsigned*)(V8 + (size_t)key_ * (NKV * HD) + gofs + dch), (LAS unsigned*)(vb + ((kb) & 15) * 1024), 16, 0, 0); } while (0)
        constexpr int KR = 8;
        u32x4 kr[KR][2];
#define DSA_KLOAD(slot, j) do { const unsigned vo_ = (unsigned)selL[16 * (j) + c] * (NKV * HD) + gofs + 16u * kq; \
        kr[slot][0] = __builtin_bit_cast(u32x4, bload(rsK, vo_, 0u)); kr[slot][1] = __builtin_bit_cast(u32x4, bload(rsK, vo_, 64u)); } while (0)
#pragma unroll
        for (int j = 0; j < KR - 1; ++j) DSA_KLOAD(j, j);
#pragma unroll
        for (int kb = 0; kb < 16; ++kb) DSA_VDMA(kb);
        f32x4 sacc[16];
#pragma unroll
        for (int j = 0; j < 16; ++j) {
            if (j + KR - 1 < 16) DSA_KLOAD((j + KR - 1) % KR, j + KR - 1);
            f32x4 a4 = {0.f, 0.f, 0.f, 0.f};
#pragma unroll
            for (int u = 0; u < 2; ++u) {
                const u32x4 kv = kr[j % KR][u];
                a4 = MFMA16F8(mk_i64(kv.x, kv.y), qf[2 * u], a4);
                a4 = MFMA16F8(mk_i64(kv.z, kv.w), qf[2 * u + 1], a4);
            }
            sacc[j] = a4;
        }
#undef DSA_KLOAD
        __builtin_amdgcn_sched_barrier(0);
        float mx = -__builtin_inff();
        if (ns < TOPK) {
            int nsl = ns - 4 * kq; asm volatile("" : "+v"(nsl));
#pragma unroll
            for (int j = 0; j < 16; ++j)
#pragma unroll
                for (int e = 0; e < 4; ++e) sacc[j][e] = (16 * j + e) < nsl ? sacc[j][e] : -__builtin_inff();
        }
        float mx2 = mx;
#pragma unroll
        for (int j = 0; j < 16; ++j) { mx = vmax3(mx, sacc[j][0], sacc[j][1]); mx2 = vmax3(mx2, sacc[j][2], sacc[j][3]); }
        mx = fmaxf(mx, mx2);
        mx = fmaxf(mx, shx(mx, 16, lane)); mx = fmaxf(mx, shx(mx, 32, lane));
        const float ml = mx * ATT_SC - 8.0f; float l = 0.f;
        long pa[8];
#pragma unroll
        for (int jj = 0; jj < 8; ++jj) {
            f32x4 p0, p1;
#pragma unroll
            for (int e = 0; e < 4; ++e) { p0[e] = __builtin_amdgcn_exp2f(sacc[2 * jj][e] * ATT_SC - ml); p1[e] = __builtin_amdgcn_exp2f(sacc[2 * jj + 1][e] * ATT_SC - ml); }
            l += ((p0[0] + p0[1]) + (p0[2] + p0[3])) + ((p1[0] + p1[1]) + (p1[2] + p1[3]));
            const u32x2 w = pack8_fp8(p0, p1);
            pa[jj] = mk_i64(w.x, w.y);
        }
        l += shx(l, 16, lane); l += shx(l, 32, lane);
        f32x4 oe[4], oo[4];
#pragma unroll
        for (int db = 0; db < 4; ++db) { oe[db] = (f32x4){0.f, 0.f, 0.f, 0.f}; oo[db] = (f32x4){0.f, 0.f, 0.f, 0.f}; }
#pragma unroll
        for (int ch = 0; ch < 4; ++ch) {
            if (ch < 3) asm volatile("s_waitcnt vmcnt(8)" ::: "memory"); else asm volatile("s_waitcnt vmcnt(0)" ::: "memory");
#pragma unroll
            for (int j2 = 0; j2 < 2; ++j2) {
                u32x2 r[8];
                if ((ch & 1) == 0) { if (j2 == 0) DSA_TR8(r[0], r[1], r[2], r[3], r[4], r[5], r[6], r[7], tra[0], tra[1], tra[2], tra[3], 0); else DSA_TR8(r[0], r[1], r[2], r[3], r[4], r[5], r[6], r[7], tra[0], tra[1], tra[2], tra[3], 4096); }
                else { if (j2 == 0) DSA_TR8(r[0], r[1], r[2], r[3], r[4], r[5], r[6], r[7], tra[0], tra[1], tra[2], tra[3], 8192); else DSA_TR8(r[0], r[1], r[2], r[3], r[4], r[5], r[6], r[7], tra[0], tra[1], tra[2], tra[3], 12288); }
#pragma unroll
                for (int db = 0; db < 4; ++db) {
                    const u32x2 x = r[2 * db], y = r[2 * db + 1];
                    const unsigned elo = __builtin_amdgcn_perm(x.y, x.x, 0x06040200u), ehi = __builtin_amdgcn_perm(y.y, y.x, 0x06040200u);
                    const unsigned olo = __builtin_amdgcn_perm(x.y, x.x, 0x07050301u), ohi = __builtin_amdgcn_perm(y.y, y.x, 0x07050301u);
                    oe[db] = MFMA16F8(pa[2 * ch + j2], mk_i64(elo, ehi), oe[db]);
                    oo[db] = MFMA16F8(pa[2 * ch + j2], mk_i64(olo, ohi), oo[db]);
                }
            }
            if (ch < 2) {
#pragma unroll
                for (int kb = 0; kb < 8; ++kb) DSA_VDMA(16 + 8 * ch + kb);
            }
        }
#undef DSA_VDMA
#define DSA_OUT(GG) do { _Pragma("unroll") for (int a = 0; a < 3; ++a) { constexpr int h_ = 3 * (GG) + 0; const int h = h_ + a; \
            const float iv = 1.0f / __int_as_float(__builtin_amdgcn_readlane(__float_as_int(l), h));   \
            if (kq == (h >> 2)) { _Pragma("unroll") for (int db = 0; db < 4; ++db) \
                *(unsigned*)(AO + (size_t)t * D + h * HD + 32 * db + 2 * c) = pk_bf16(oe[db][h & 3] * iv, oo[db][h & 3] * iv); } } } while (0)
        if (g == 0) DSA_OUT(0); else if (g == 1) DSA_OUT(1); else if (g == 2) DSA_OUT(2); else DSA_OUT(3);
#undef DSA_OUT
        lds_fence();
    }
}

#ifndef PROBE_VDMA2
#define PROBE_VDMA2 0
#endif
DI void dsa_phase(const bf16_t* Q, const unsigned char* K8, const unsigned char* V8, const unsigned short* SEL, const int* NSEL, bf16_t* AO, LAS unsigned char* vb, LAS unsigned char* sl, int gw, int W, int lane) {
    const int c = lane & 15, kq = lane >> 4;
    const __amdgpu_buffer_rsrc_t rsK = __builtin_amdgcn_make_buffer_rsrc((void*)uni_ptr((const bf16_t*)K8), (short)0, S * NKV * HD, 0x00020000);
    unsigned tra[4];
    {
        const int q = (lane >> 2) & 3, p = lane & 3, sw = ((kq & 1) << 1) | (q >> 1);
#pragma unroll
        for (int db = 0; db < 4; ++db) tra[db] = (unsigned)(unsigned long long)vb + (unsigned)((4 * kq + q) * 128 + ((((db ^ sw) << 1) | (p >> 1)) << 4) + 8 * (p & 1));
    }
    const int dch = ((lane & 7) ^ (((lane >> 4) & 3) << 1)) * 16;
    int t = gw;
    if (t >= S) return;
    LAS unsigned short* selC = (LAS unsigned short*)sl;
    LAS unsigned short* selN = selC + 256;
    { const u32x2 sv = *(const u32x2*)(SEL + (size_t)t * TOPK + 4 * lane); *(LAS u32x2*)(selC + 4 * lane) = sv; }
    int ns = NSEL[t];
    lds_fence();
    long qf[4];
#define DSA_QCVT(q0, q1, u) do { const u32x2 f0_ = pack8_fp8((f32x4){bf_lo(q0.x), bf_hi(q0.x), bf_lo(q0.y), bf_hi(q0.y)}, (f32x4){bf_lo(q0.z), bf_hi(q0.z), bf_lo(q0.w), bf_hi(q0.w)}); \
        const u32x2 f1_ = pack8_fp8((f32x4){bf_lo(q1.x), bf_hi(q1.x), bf_lo(q1.y), bf_hi(q1.y)}, (f32x4){bf_lo(q1.z), bf_hi(q1.z), bf_lo(q1.w), bf_hi(q1.w)}); \
        qf[2 * (u)] = mk_i64(f0_.x, f0_.y); qf[2 * (u) + 1] = mk_i64(f1_.x, f1_.y); } while (0)
    const int cq = c < NH ? c : 0;
    {
#pragma unroll
        for (int u = 0; u < 2; ++u) { const u32x4* qp = (const u32x4*)(Q + ((size_t)t * NH + cq) * HD + 64 * u + 16 * kq); const u32x4 q0 = qp[0], q1 = qp[1]; DSA_QCVT(q0, q1, u); }
    }
    constexpr int KR = 8;
    u32x4 kr[KR][2];
#define DSA_KLOAD(slot, j, selp, gofs_) do { const unsigned vo_ = (unsigned)(selp)[16 * (j) + c] * (NKV * HD) + (gofs_) + 16u * kq; \
        kr[slot][0] = __builtin_bit_cast(u32x4, bload(rsK, vo_, 0u)); kr[slot][1] = __builtin_bit_cast(u32x4, bload(rsK, vo_, 64u)); } while (0)
#define DSA_VDMA(kb, selp, gofs_) do { const unsigned key_ = (unsigned)(selp)[8 * (kb) + (lane >> 3)] & (unsigned)(S - 1); \
        __builtin_amdgcn_global_load_lds((const unsigned*)(V8 + (size_t)key_ * (NKV * HD) + (gofs_) + dch), (LAS unsigned*)(vb + ((kb) & 15) * 1024), 16, 0, 0); \
        if (PROBE_VDMA2) __builtin_amdgcn_global_load_lds((const unsigned*)(V8 + (size_t)(key_ ^ 1u) * (NKV * HD) + (gofs_) + dch), (LAS unsigned*)(sl - (gw & 7) * 1024 + 8192), 16, 0, 0); } while (0)
#pragma unroll
    for (int j = 0; j < KR - 1; ++j) DSA_KLOAD(j, j, selC, 0u);
#pragma unroll
    for (int kb = 0; kb < 16; ++kb) DSA_VDMA(kb, selC, 0u);
    for (;;) {
        const int tn = t + W; const bool has_next = tn < S;
        u32x2 svn = {0u, 0u}; int nsn = 0; u32x4 qr[4] = {{0u, 0u, 0u, 0u}, {0u, 0u, 0u, 0u}, {0u, 0u, 0u, 0u}, {0u, 0u, 0u, 0u}};
        if (has_next) {
            svn = *(const u32x2*)(SEL + (size_t)tn * TOPK + 4 * lane); nsn = NSEL[tn];
#pragma unroll
            for (int u = 0; u < 2; ++u) { const u32x4* qp = (const u32x4*)(Q + ((size_t)tn * NH + cq) * HD + 64 * u + 16 * kq); qr[2 * u] = qp[0]; qr[2 * u + 1] = qp[1]; }
        }
#pragma unroll 1
        for (int g = 0; g < NKV; ++g) {
            const unsigned gofs = (unsigned)g * HD;
            const bool more = g < NKV - 1 || has_next;
            LAS const unsigned short* selX = g < NKV - 1 ? selC : selN; const unsigned gofsX = g < NKV - 1 ? gofs + HD : 0u;
            f32x4 sacc[16];
#pragma unroll
            for (int j = 0; j < 16; ++j) {
                if (j + KR - 1 < 16) DSA_KLOAD((j + KR - 1) % KR, j + KR - 1, selC, gofs);
                f32x4 a4 = {0.f, 0.f, 0.f, 0.f};
#pragma unroll
                for (int u = 0; u < 2; ++u) {
                    const u32x4 kv = kr[j % KR][u];
                    a4 = MFMA16F8(mk_i64(kv.x, kv.y), qf[2 * u], a4);
                    a4 = MFMA16F8(mk_i64(kv.z, kv.w), qf[2 * u + 1], a4);
                }
                sacc[j] = a4;
            }
            if (g == 1 && has_next) { *(LAS u32x2*)(selN + 4 * lane) = svn; lds_fence(); }
            if (more) {
#pragma unroll
                for (int j = 0; j < KR - 1; ++j) DSA_KLOAD(j, j, selX, gofsX);
            }
            float mx = -__builtin_inff();
            int nsl = ns - 4 * kq; asm volatile("" : "+v"(nsl));
#pragma unroll
            for (int j = 0; j < 16; ++j)
#pragma unroll
                for (int e = 0; e < 4; ++e) { const float s_ = (16 * j + e) < nsl ? sacc[j][e] : -__builtin_inff(); sacc[j][e] = s_; mx = fmaxf(mx, s_); }
            mx = fmaxf(mx, shx(mx, 16, lane)); mx = fmaxf(mx, shx(mx, 32, lane));
            const float ml = mx * ATT_SC - 8.0f; float l = 0.f;
            long pa[8];
#pragma unroll
            for (int jj = 0; jj < 8; ++jj) {
                f32x4 p0, p1;
#pragma unroll
                for (int e = 0; e < 4; ++e) { p0[e] = __builtin_amdgcn_exp2f(sacc[2 * jj][e] * ATT_SC - ml); p1[e] = __builtin_amdgcn_exp2f(sacc[2 * jj + 1][e] * ATT_SC - ml); }
                l += ((p0[0] + p0[1]) + (p0[2] + p0[3])) + ((p1[0] + p1[1]) + (p1[2] + p1[3]));
                const u32x2 w = pack8_fp8(p0, p1);
                pa[jj] = mk_i64(w.x, w.y);
            }
            l += shx(l, 16, lane); l += shx(l, 32, lane);
            f32x4 oe[4], oo[4];
#pragma unroll
            for (int db = 0; db < 4; ++db) { oe[db] = (f32x4){0.f, 0.f, 0.f, 0.f}; oo[db] = (f32x4){0.f, 0.f, 0.f, 0.f}; }
#pragma unroll
            for (int ch = 0; ch < 4; ++ch) {
                if (ch == 0) asm volatile("s_waitcnt vmcnt(26)" ::: "memory");
                else if (ch == 2) { if (PROBE_VDMA2) asm volatile("s_waitcnt vmcnt(16)" ::: "memory"); else asm volatile("s_waitcnt vmcnt(8)" ::: "memory"); }
                else if (ch == 3) { if (more) { if (PROBE_VDMA2) asm volatile("s_waitcnt vmcnt(16)" ::: "memory"); else asm volatile("s_waitcnt vmcnt(8)" ::: "memory"); } else asm volatile("s_waitcnt vmcnt(0)" ::: "memory"); }
#pragma unroll
                for (int j2 = 0; j2 < 2; ++j2) {
                    u32x2 r[8];
                    if ((ch & 1) == 0) { if (j2 == 0) DSA_TR8(r[0], r[1], r[2], r[3], r[4], r[5], r[6], r[7], tra[0], tra[1], tra[2], tra[3], 0); else DSA_TR8(r[0], r[1], r[2], r[3], r[4], r[5], r[6], r[7], tra[0], tra[1], tra[2], tra[3], 4096); }
                    else { if (j2 == 0) DSA_TR8(r[0], r[1], r[2], r[3], r[4], r[5], r[6], r[7], tra[0], tra[1], tra[2], tra[3], 8192); else DSA_TR8(r[0], r[1], r[2], r[3], r[4], r[5], r[6], r[7], tra[0], tra[1], tra[2], tra[3], 12288); }
#pragma unroll
                    for (int db = 0; db < 4; ++db) {
                        const u32x2 x = r[2 * db], y = r[2 * db + 1];
                        const unsigned elo = __builtin_amdgcn_perm(x.y, x.x, 0x06040200u), ehi = __builtin_amdgcn_perm(y.y, y.x, 0x06040200u);
                        const unsigned olo = __builtin_amdgcn_perm(x.y, x.x, 0x07050301u), ohi = __builtin_amdgcn_perm(y.y, y.x, 0x07050301u);
                        oe[db] = MFMA16F8(pa[2 * ch + j2], mk_i64(elo, ehi), oe[db]);
                        oo[db] = MFMA16F8(pa[2 * ch + j2], mk_i64(olo, ohi), oo[db]);
                    }
                }
                if (ch < 2) {
#pragma unroll
                    for (int kb = 0; kb < 8; ++kb) DSA_VDMA(16 + 8 * ch + kb, selC, gofs);
                } else if (more) {
#pragma unroll
                    for (int kb = 0; kb < 8; ++kb) DSA_VDMA(8 * (ch - 2) + kb, selX, gofsX);
                }
            }
#pragma unroll
            for (int a = 0; a < 3; ++a) {
                const int h = 3 * g + a, he = h & 3;
                const float iv = 1.0f / __int_as_float(__builtin_amdgcn_readlane(__float_as_int(l), h));
                if (kq == (h >> 2)) {
#pragma unroll
                    for (int db = 0; db < 4; ++db) {
                        const float ve = he == 0 ? oe[db][0] : he == 1 ? oe[db][1] : he == 2 ? oe[db][2] : oe[db][3];
                        const float vo = he == 0 ? oo[db][0] : he == 1 ? oo[db][1] : he == 2 ? oo[db][2] : oo[db][3];
                        *(unsigned*)(AO + (size_t)t * D + h * HD + 32 * db + 2 * c) = pk_bf16(ve * iv, vo * iv);
                    }
                }
            }
        }
        if (!has_next) break;
        t = tn; ns = nsn;
        { LAS unsigned short* x_ = selC; selC = selN; selN = x_; }
        DSA_QCVT(qr[0], qr[1], 0); DSA_QCVT(qr[2], qr[3], 1);
    }
#undef DSA_KLOAD
#undef DSA_VDMA
#undef DSA_QCVT
}

DI void moba_gate_unit(int unit, const bf16_t* Q, const float* KMEAN, unsigned short* ITEMS, int* NITEMS, int* IB, LAS unsigned char* lds, int tid) {
    const int cur = unit >> 2, g = unit & 3, nv = cur < 3 ? cur : 3;
    LAS float* km = (LAS float*)lds;
    LAS int* bcnt = (LAS int*)(lds + 32768);
    LAS int* boff = bcnt + 64;
    LAS int* ibase = boff + 64;
    LAS int* bfill = ibase + 68;
    LAS unsigned* rowsel = (LAS unsigned*)(bfill + 64);
    LAS unsigned short* sorted = (LAS unsigned short*)(rowsel + 768);
    if (tid < 64) { bcnt[tid] = 0; bfill[tid] = 0; }
    for (int i = tid; i < cur * 32; i += NTHREADS) *(LAS f32x4*)(km + 4 * i) = *(const f32x4*)(KMEAN + (size_t)g * NBLK * HD + 4 * i);
    __syncthreads();
    if (nv > 0) {
        for (int row = tid; row < 768; row += NTHREADS) {
            const int tl = row / 3, rr = row - 3 * tl, t = cur * MBLK + tl;
            const u32x4* qp = (const u32x4*)(Q + ((size_t)t * NH + 3 * g + rr) * HD);
            u32x4 qv[16];
#pragma unroll
            for (int i = 0; i < 16; ++i) qv[i] = qp[i];
            float v0 = -__builtin_inff(), v1 = v0, v2 = v0; int i0 = 0, i1 = 0, i2 = 0;
            for (int n = 0; n < cur; ++n) {
                float dot = 0.f;
#pragma unroll
                for (int i = 0; i < 16; ++i) {
                    const f32x4 ka = *(const LAS f32x4*)(km + n * HD + 8 * i), kb = *(const LAS f32x4*)(km + n * HD + 8 * i + 4);
                    dot = fmaf(bf_lo(qv[i].x), ka[0], dot); dot = fmaf(bf_hi(qv[i].x), ka[1], dot); dot = fmaf(bf_lo(qv[i].y), ka[2], dot); dot = fmaf(bf_hi(qv[i].y), ka[3], dot);
                    dot = fmaf(bf_lo(qv[i].z), kb[0], dot); dot = fmaf(bf_hi(qv[i].z), kb[1], dot); dot = fmaf(bf_lo(qv[i].w), kb[2], dot); dot = fmaf(bf_hi(qv[i].w), kb[3], dot);
                }
                if (dot > v0) { v2 = v1; i2 = i1; v1 = v0; i1 = i0; v0 = dot; i0 = n; }
                else if (dot > v1) { v2 = v1; i2 = i1; v1 = dot; i1 = n; }
                else if (dot > v2) { v2 = dot; i2 = n; }
            }
            rowsel[row] = (unsigned)i0 | ((unsigned)i1 << 8) | ((unsigned)i2 << 16);
            atomicAdd((int*)(bcnt + i0), 1); if (nv > 1) atomicAdd((int*)(bcnt + i1), 1); if (nv > 2) atomicAdd((int*)(bcnt + i2), 1);
        }
    }
    __syncthreads();
    if (tid == 0) { int o = 0, ib = 0; for (int n = 0; n < 64; ++n) { boff[n] = o; ibase[n] = ib; const int c = n < cur ? bcnt[n] : 0; o += c; ib += (c + 31) >> 5; } ibase[64] = ib; }
    __syncthreads();
    if (nv > 0) {
        for (int row = tid; row < 768; row += NTHREADS) {
            const int tl = row / 3, rr = row - 3 * tl; const unsigned rs = rowsel[row];
            for (int j = 0; j < nv; ++j) { const int n = (rs >> (8 * j)) & 255; const int pos = atomicAdd((int*)(bfill + n), 1); sorted[boff[n] + pos] = (unsigned short)((tl << 4) | (rr << 2) | j); }
        }
    }
    __syncthreads();
    const int wave = tid >> 6, lane = tid & 63;
    unsigned short* ib = ITEMS + (size_t)unit * ITEM_CAP * ITEM_U16;
    for (int n = wave; n < cur; n += NWAVES) {
        const int c = bcnt[n], b0 = ibase[n], o0 = boff[n];
        for (int i = lane; i < c; i += 64) ib[(size_t)(b0 + (i >> 5)) * ITEM_U16 + 8 + (i & 31)] = sorted[o0 + i];
        for (int k = lane; k < ((c + 31) >> 5); k += 64) { ib[(size_t)(b0 + k) * ITEM_U16] = (unsigned short)n; const int rem = c - 32 * k; ib[(size_t)(b0 + k) * ITEM_U16 + 1] = (unsigned short)(rem < 32 ? rem : 32); }
    }
    if (tid == 0) NITEMS[unit] = ibase[64];
    if (tid < 65) IB[unit * 68 + tid] = ibase[tid];
    __syncthreads();
}

DI void moba_item(int unit, int k, const bf16_t* Q, const bf16_t* KBLK, const bf16_t* VT, const unsigned short* ITEMS, const int* NITEMS, bf16_t* PO, float* PML, int lane) {
    const int cur = unit >> 2, g = unit & 3, r = lane & 31, h = lane >> 5;
    int n, count, tl, rr, j; bool causal;
    if (k < ITEM_CAP) {
        if (k >= NITEMS[unit]) return;
        const unsigned short* it = ITEMS + ((size_t)unit * ITEM_CAP + k) * ITEM_U16;
        n = it[0]; count = it[1];
        const unsigned rec = it[8 + (r < count ? r : 0)];
        tl = rec >> 4; rr = (rec >> 2) & 3; j = rec & 3; causal = false;
    } else {
        const int rho = 32 * (k - ITEM_CAP) + r;
        n = cur; count = 32; tl = rho / 3; rr = rho - 3 * tl; j = 3; causal = true;
    }
    const int t = cur * MBLK + tl, hq = 3 * g + rr;
    f32x16 oacc[4]; float mlog, l;
    n = __builtin_amdgcn_readfirstlane(n);
    attn_item(Q + ((size_t)t * NH + hq) * HD, KBLK + (size_t)(g * NBLK + n) * HD * MBLK, VT + (size_t)(g * NBLK + n) * HD * MBLK, causal, n * MBLK, t, lane, oacc, mlog, l);
    if (r < count) {
        const size_t slot = ((size_t)t * NH + hq) * 4 + j;
        const float inv = 1.0f / l;
        bf16_t* op = PO + slot * HD;
#pragma unroll
        for (int dt = 0; dt < 4; ++dt)
#pragma unroll
            for (int q4 = 0; q4 < 4; ++q4) {
                u32x2 w; w.x = pk_bf16(oacc[dt][4 * q4] * inv, oacc[dt][4 * q4 + 1] * inv); w.y = pk_bf16(oacc[dt][4 * q4 + 2] * inv, oacc[dt][4 * q4 + 3] * inv);
                *(u32x2*)(op + 32 * dt + 8 * q4 + 4 * h) = w;
            }
        if (h == 0) { f32x2 ml = {mlog, l}; *(f32x2*)(PML + slot * 2) = ml; }
    }
}

DI void attn_qk_lds(const bf16x8 (&qf)[8], LAS const unsigned char* ldsK, int lane, f32x16 (&sacc)[8]) {
#pragma unroll
    for (int mt = 0; mt < 8; ++mt) {
#pragma unroll
        for (int j = 0; j < 16; ++j) sacc[mt][j] = 0.f;
#pragma unroll
        for (int ks = 0; ks < 8; ++ks) { const bf16x8 a = *(LAS const bf16x8*)(ldsK + (mt * 8 + ks) * 1024 + lane * 16); sacc[mt] = MFMA32(a, qf[ks], sacc[mt]); }
    }
}
DI void attn_sm_lds(f32x16 (&sacc)[8], bool causal, int kbase, int tq, int lane, u32x4 (&pw)[8][2], float& mlog, float& lsum) {
    const int h = lane >> 5;
    float mx = -__builtin_inff();
    if (causal) {
        const int lim = tq - kbase - 4 * h;
#pragma unroll
        for (int mt = 0; mt < 8; ++mt)
#pragma unroll
            for (int j = 0; j < 16; ++j) sacc[mt][j] = (32 * mt + (j & 3) + 8 * (j >> 2)) > lim ? -__builtin_inff() : sacc[mt][j];
    }
    float mx2 = mx;
#pragma unroll
    for (int mt = 0; mt < 8; ++mt)
#pragma unroll
        for (int j = 0; j < 16; j += 4) { mx = vmax3(mx, sacc[mt][j], sacc[mt][j + 1]); mx2 = vmax3(mx2, sacc[mt][j + 2], sacc[mt][j + 3]); }
    mx = fmaxf(mx, mx2);
    mx = fmaxf(mx, shx(mx, 32, lane));
    mlog = mx * ATT_SC;
    float l = 0.f;
#pragma unroll
    for (int mt = 0; mt < 8; ++mt)
#pragma unroll
        for (int s2 = 0; s2 < 2; ++s2) {
            float p[8];
#pragma unroll
            for (int j = 0; j < 8; ++j) { p[j] = __builtin_amdgcn_exp2f(sacc[mt][8 * s2 + j] * ATT_SC - mlog); l += p[j]; }
            pw[mt][s2].x = pk_bf16(p[0], p[1]); pw[mt][s2].y = pk_bf16(p[2], p[3]); pw[mt][s2].z = pk_bf16(p[4], p[5]); pw[mt][s2].w = pk_bf16(p[6], p[7]);
        }
    l += shx(l, 32, lane);
    lsum = l;
}
DI void attn_pv_lds(const u32x4 (&pw)[8][2], LAS const unsigned char* ldsV, int lane, f32x16 (&oacc)[4]) {
#pragma unroll
    for (int dt = 0; dt < 4; ++dt)
#pragma unroll
        for (int j = 0; j < 16; ++j) oacc[dt][j] = 0.f;
#pragma unroll
    for (int mt = 0; mt < 8; ++mt)
#pragma unroll
        for (int s2 = 0; s2 < 2; ++s2) {
            const bf16x8 pb = __builtin_bit_cast(bf16x8, pw[mt][s2]);
#pragma unroll
            for (int dt = 0; dt < 4; ++dt) { const bf16x8 a = *(LAS const bf16x8*)(ldsV + (((dt * 8 + mt) * 2) + s2) * 1024 + lane * 16); oacc[dt] = MFMA32(a, pb, oacc[dt]); }
        }
}
#ifndef MOBA_DESYNC
#define MOBA_DESYNC 0
#endif
#ifndef MOBA_TOUCH
#define MOBA_TOUCH 1
#endif
constexpr int MPART = 32;
DI void moba_phase_lds(const bf16_t* Q, const bf16_t* KBLK, const bf16_t* VTB, const unsigned short* ITEMS, const int* IB, bf16_t* PO, float* PML, LAS unsigned char* lds, int tid, int bid, int G) {
    const int lane = tid & 63, wave = __builtin_amdgcn_readfirstlane(tid >> 6), r = lane & 31, h = lane >> 5;
    LAS int* Tt = (LAS int*)(lds + STAGE_LDS + 1024);
    LAS int* Ts = Tt + 256;
    LAS int* PP = Ts + 256;
    if (tid < 256) {
        const int g = tid >> 6, n = tid & 63; int ts = 0;
        for (int cur = n + 1; cur < NBLK; ++cur) { const int* ib = IB + (cur * 4 + g) * 68; ts += ib[n + 1] - ib[n]; }
        Ts[tid] = ts; Tt[tid] = ts + OWN_ITEMS;
    }
    __syncthreads();
    if (tid == 0) { int p = 0; for (int i = 0; i < 256; ++i) { PP[i] = p; p += (Tt[i] + MPART - 1) / MPART; } PP[256] = p; }
    __syncthreads();
    const int P = PP[256];
    for (int p = bid; p < P; p += G) {
        int lo_ = 0, hi_ = 256;
        while (hi_ - lo_ > 1) { const int mid = (lo_ + hi_) >> 1; if (PP[mid] <= p) lo_ = mid; else hi_ = mid; }
        const int task = __builtin_amdgcn_readfirstlane(lo_), g = task >> 6, n = task & 63;
        const int q0 = (p - PP[task]) * MPART, Tsel = Ts[task], Ttot = Tt[task];
        {
            const u32x4* ksrc = (const u32x4*)(KBLK + (size_t)(g * NBLK + n) * HD * MBLK); const u32x4* vsrc = (const u32x4*)(VTB + (size_t)(g * NBLK + n) * HD * MBLK);
            u32x4 kt[8], vt[8];
            int tid_s = tid; asm volatile("" : "+v"(tid_s));
#pragma unroll
            for (int i = 0; i < 8; ++i) { kt[i] = ksrc[tid_s + 512 * i]; vt[i] = vsrc[tid_s + 512 * i]; }
#pragma unroll
            for (int i = 0; i < 8; ++i) { ((LAS u32x4*)lds)[tid_s + 512 * i] = kt[i]; ((LAS u32x4*)(lds + 65536))[tid_s + 512 * i] = vt[i]; }
        }
        int cnt_l = 0, ib_l = 0;
        { const int cur_l = n + 1 + lane; if (cur_l < NBLK) { const int* ib = IB + (cur_l * 4 + g) * 68; ib_l = ib[n]; cnt_l = ib[n + 1] - ib_l; } }
        int incl = cnt_l;
        int lane_s = lane; asm volatile("" : "+v"(lane_s));
#pragma unroll
        for (int o = 1; o < 64; o <<= 1) { const int v = __builtin_amdgcn_ds_bpermute((lane_s - o) << 2, incl); if (lane_s >= o) incl += v; }
        const int excl = incl - cnt_l;
        __syncthreads();
#define MOBA_ITEM(q_, OWN, COUNT, CUR, REC) do { int k_; \
            if ((q_) < Tsel) { const unsigned long long m_ = __ballot(excl <= (q_) && (q_) < incl); const int src_ = __builtin_ctzll(m_); \
                CUR = n + 1 + src_; k_ = __builtin_amdgcn_readlane(ib_l, src_) + ((q_) - __builtin_amdgcn_readlane(excl, src_)); OWN = false; } \
            else { CUR = n; k_ = (q_) - Tsel; OWN = true; } \
            if (!OWN) { const unsigned short* it_ = ITEMS + ((size_t)(CUR * 4 + g) * ITEM_CAP + k_) * ITEM_U16; COUNT = __builtin_amdgcn_readfirstlane((int)it_[1]); \
                REC = it_[8 + (r < COUNT ? r : 0)]; } \
            else { const int rho_ = 32 * k_ + r, tl_ = rho_ / 3; COUNT = 32; REC = (unsigned)((tl_ << 4) | ((rho_ - 3 * tl_) << 2) | 3); } } while (0)
#define MOBA_QLOAD(CUR, REC) do { const bf16_t* qrow_ = Q + ((size_t)((CUR) * MBLK + (int)((REC) >> 4)) * NH + 3 * g + (int)(((REC) >> 2) & 3)) * HD; \
            _Pragma("unroll") for (int ks = 0; ks < 8; ++ks) qf[ks] = *(const bf16x8*)(qrow_ + 16 * ks + 8 * h); } while (0)
        if (MOBA_DESYNC && wave >= 4) { __builtin_amdgcn_s_sleep(MOBA_DESYNC); __builtin_amdgcn_s_sleep(MOBA_DESYNC); }
        int q = q0 + wave;
        bool own = false; int count = 0, cur = 0; unsigned rec = 0u;
        bf16x8 qf[8];
        if (q < Ttot) { MOBA_ITEM(q, own, count, cur, rec); MOBA_QLOAD(cur, rec); }
        for (int j = 0; j < MPART / NWAVES; ++j) {
            if (q >= Ttot) break;
            const int qn = q + NWAVES; const bool hasn = (j + 1 < MPART / NWAVES) && qn < Ttot;
            bool ownn = false; int countn = 0, curn = 0; unsigned recn = 0u;
            if (hasn) MOBA_ITEM(qn, ownn, countn, curn, recn);
            __builtin_amdgcn_sched_barrier(0);
            f32x16 sacc[8];
            attn_qk_lds(qf, (LAS const unsigned char*)lds, lane, sacc);
            __builtin_amdgcn_sched_barrier(0);
            u32x4 pw[8][2]; float mlog, l;
            const int t = cur * MBLK + (int)(rec >> 4);
            attn_sm_lds(sacc, own, n * MBLK, t, lane, pw, mlog, l);
            __builtin_amdgcn_sched_barrier(0);
            if (hasn) MOBA_QLOAD(curn, recn);
            __builtin_amdgcn_sched_barrier(0);
            f32x16 oacc[4];
            attn_pv_lds(pw, (LAS const unsigned char*)(lds + 65536), lane, oacc);
            if (r < count) {
                const size_t slot = ((size_t)t * NH + 3 * g + (int)((rec >> 2) & 3)) * 4 + (rec & 3);
                const float inv = 1.0f / l;
                bf16_t* op = PO + slot * HD;
#pragma unroll
                for (int dt = 0; dt < 4; ++dt)
#pragma unroll
                    for (int q4 = 0; q4 < 4; ++q4) {
                        u32x2 w; w.x = pk_bf16(oacc[dt][4 * q4] * inv, oacc[dt][4 * q4 + 1] * inv); w.y = pk_bf16(oacc[dt][4 * q4 + 2] * inv, oacc[dt][4 * q4 + 3] * inv);
                        *(u32x2*)(op + 32 * dt + 8 * q4 + 4 * h) = w;
                    }
                if (h == 0) { f32x2 ml = {mlog, l}; *(f32x2*)(PML + slot * 2) = ml; }
            }
            __builtin_amdgcn_sched_barrier(0);
            own = ownn; count = countn; cur = curn; rec = recn; q = qn;
        }
#undef MOBA_ITEM
#undef MOBA_QLOAD
        __syncthreads();
    }
}

DI void moba_merge(const bf16_t* PO, const float* PML, bf16_t* AO, int gtid, int GT) {
    for (int it = gtid; it < S * NH * 16; it += GT) {
        const int c = it & 15, th = it >> 4, t = th / NH, hq = th - t * NH;
        const int cur = t >> 8, nv = cur < 3 ? cur : 3;
        float mj[4], lj[4]; float M = -__builtin_inff();
#pragma unroll
        for (int j = 0; j < 4; ++j) {
            const bool valid = (j == 3) || (j < nv);
            const f32x2 ml = valid ? *(const f32x2*)(PML + ((size_t)th * 4 + j) * 2) : (f32x2){-__builtin_inff(), 0.f};
            mj[j] = ml[0]; lj[j] = ml[1]; M = fmaxf(M, mj[j]);
        }
        float o[8], wsum = 0.f;
#pragma unroll
        for (int e = 0; e < 8; ++e) o[e] = 0.f;
#pragma unroll
        for (int j = 0; j < 4; ++j) {
            const bool valid = (j == 3) || (j < nv);
            if (valid) {
                const float w = lj[j] * __builtin_amdgcn_exp2f(mj[j] - M); wsum += w;
                const u32x4 v = *(const u32x4*)(PO + ((size_t)th * 4 + j) * HD + 8 * c);
                o[0] = fmaf(w, bf_lo(v.x), o[0]); o[1] = fmaf(w, bf_hi(v.x), o[1]); o[2] = fmaf(w, bf_lo(v.y), o[2]); o[3] = fmaf(w, bf_hi(v.y), o[3]);
                o[4] = fmaf(w, bf_lo(v.z), o[4]); o[5] = fmaf(w, bf_hi(v.z), o[5]); o[6] = fmaf(w, bf_lo(v.w), o[6]); o[7] = fmaf(w, bf_hi(v.w), o[7]);
            }
        }
        const float inv = 1.0f / wsum;
        u32x4 w; w.x = pk_bf16(o[0] * inv, o[1] * inv); w.y = pk_bf16(o[2] * inv, o[3] * inv); w.z = pk_bf16(o[4] * inv, o[5] * inv); w.w = pk_bf16(o[6] * inv, o[7] * inv);
        *(u32x4*)(AO + (size_t)t * D + hq * HD + 8 * c) = w;
    }
}
#ifndef MK_ONE_LAUNCH
#define MK_ONE_LAUNCH 1
#endif
#ifndef FP8_MASK
#define FP8_MASK 0xE
#endif
#ifndef DN8_MASK
#define DN8_MASK 0xE
#endif
#ifndef MEMKV_IN_PROJ
#define MEMKV_IN_PROJ 0
#endif
#ifndef IDXDSA_FUSED
#define IDXDSA_FUSED 0
#endif
#ifndef REP_ALL
#define REP_ALL 1
#endif
#ifndef REP_CONV
#define REP_CONV 1
#endif
#ifndef REP_NORM
#define REP_NORM 1
#endif
#ifndef REP_IDX
#define REP_IDX 1
#endif
#ifndef REP_DSA
#define REP_DSA 1
#endif
#ifndef REP_M2
#define REP_M2 1
#endif
#ifndef REP_GU
#define REP_GU 1
#endif
#ifndef REP_M1
#define REP_M1 1
#endif
#ifndef REP_MERGE
#define REP_MERGE 1
#endif
#ifndef REP_PROJ
#define REP_PROJ 1
#endif
#ifndef REP_DOWN
#define REP_DOWN 1
#endif
#ifndef REP_KVPOST
#define REP_KVPOST 1
#endif
#ifndef REP_WOUT
#define REP_WOUT 1
#endif
#ifndef REP_PROJB
#define REP_PROJB 1
#endif
#ifndef REP_FINAL
#define REP_FINAL 1
#endif
#ifndef REP_BAR
#define REP_BAR 1
#endif
struct Args {
    const float* in[19]; float* out; unsigned char* ws; int ph_lo, ph_hi;
};
static_assert(sizeof(Args) == 176, "Args layout");
enum { I_X = 0, I_MEM, I_POS, I_F1N, I_F1GU, I_F1DN, I_ATN, I_MEMN, I_AWIN, I_IKN, I_BWIN, I_WMKV, I_WOUT, I_F2N, I_F2GU, I_F2DN, I_KVN, I_WKV, I_FINN };
#define CAS __attribute__((address_space(4)))

#define RS_PREPASS(so_, ss_) LAS float* RSL = (LAS float*)(lds + STAGE_LDS + 1024); int rowbase = 0; \
    { pg8::Unit u0_; if ((so_).next(0, u0_)) { rowbase = (u0_.pm & ~7) * pg8::BM; rs_prepass((ss_), rowbase, RSL, tid); } else RSL = nullptr; }
#define INP(i) (*(const float* const CAS*)(kp + 8 * (i)))
#define P_COS ((float*)(ws + WS_ROPE))
#define P_SIN ((float*)(ws + WS_ROPE) + (size_t)S * 64)
#define P_H ((bf16_t*)(ws + WS_H))
#define P_H8 ((unsigned char*)(ws + WS_H8))
#define P_ACT ((bf16_t*)(ws + WS_ACT))
#define P_AO ((bf16_t*)(ws + WS_AO))
#define P_AOB ((bf16_t*)X)
#define P_Q ((bf16_t*)(ws + WS_Q))
#define P_K ((bf16_t*)(ws + WS_K))
#define P_V ((bf16_t*)(ws + WS_V))
#define P_QI ((bf16_t*)(ws + WS_QI))
#define P_VT ((bf16_t*)(ws + WS_QI))
#define P_KBLK ((bf16_t*)(ws + WS_QI + (size_t)NKV * NBLK * MBLK * HD * 2))
#define P_KI ((bf16_t*)(ws + WS_KI))
#define P_WI ((float*)(ws + WS_WI))
#define P_QM ((bf16_t*)(ws + WS_QM))
#define P_SEL ((unsigned short*)(ws + WS_SEL))
#define P_NSEL ((int*)(ws + WS_NSEL))
#define P_MEMK ((bf16_t*)(ws + WS_MEMK))
#define P_MEMVT ((bf16_t*)(ws + WS_MEMVT))
#define P_KMEAN ((float*)(ws + WS_KMEAN))
#define P_ITEMS ((unsigned short*)(ws + WS_ITEMS))
#define P_NITEMS ((int*)(ws + WS_NITEMS))
#define P_IB ((int*)(ws + WS_IB))
#define P_PO ((bf16_t*)(ws + WS_PO))
#define P_PML ((float*)(ws + WS_PML))
#define P_WGU(i) ((bf16_t*)(ws + ((i) ? WS_WGU1 : WS_WGU0)))
#define P_WDN(i) ((bf16_t*)(ws + ((i) ? WS_WDN1 : WS_WDN0)))
#define P_WIN ((bf16_t*)(ws + WS_WIN))
#define P_WOUT ((bf16_t*)(ws + WS_WOUT))
#define P_WKV ((bf16_t*)(ws + WS_WKV))
#define P_SS(i) ((float*)(ws + WS_SS) + (size_t)(i) * S * 32)

DI void conv_layer(const CAS char* kp, unsigned char* ws, int L, int bid, int G, int lane, int wave) {
                {
                    constexpr int T_GU = (NGU / 64) * (D / 256), T_DN = (D / 64) * (FF / 256), T_WO = (D / 64) * (D / 256), T_WINA = (NPA / 64) * (D / 256), T_WINB = (B_IN / 64) * (D / 256), T_KV = (KVW / 64) * (D / 256);
                    const int t_in = L == 0 ? T_WINA : T_WINB + T_KV, total = 2 * T_GU + 2 * T_DN + T_WO + t_in;
                    float zf = 0.f; asm volatile("" : "+v"(zf));
#if CONV_WIDE == 1
                    const int kg = wave, nq = lane;
#elif CONV_WIDE == 2
                    const int kg = (lane & 15) + 16 * (wave >> 2), nq = (lane >> 4) + 4 * (wave & 3);
#else
                    const int kg = (lane & 7) + 8 * (wave >> 1), nq = (lane >> 3) + 8 * (wave & 1);
#endif
#define CONV_PICK(J, T) { int t_ = (T); \
                        if (t_ < T_GU) { J.src = INP(I_F1GU) + (size_t)L * D * NGU; J.gain = INP(I_F1N) + (size_t)L * D; J.dst = (unsigned char*)P_WGU(0); J.ld = NGU; J.K = D; J.type = CT_GU; J.fp8 = (FP8_MASK >> (2 * L)) & 1; conv_job_tile(J, t_, NGU / 64); } \
                        else if ((t_ -= T_GU) < T_DN) { J.src = INP(I_F1DN) + (size_t)L * FF * D; J.gain = nullptr; J.dst = (unsigned char*)P_WDN(0); J.ld = D; J.K = FF; J.type = CT_ID; J.fp8 = (DN8_MASK >> (2 * L)) & 1; conv_job_tile(J, t_, D / 64); } \
                        else if ((t_ -= T_DN) < t_in) { \
                            if (L == 0) { J.src = INP(I_AWIN); J.gain = INP(I_ATN); J.dst = (unsigned char*)P_WIN; J.ld = A_IN; J.K = D; J.type = CT_WINA; J.fp8 = 0; conv_job_tile(J, t_, NPA / 64); } \
                            else if (t_ < T_KV) { J.src = INP(I_WKV); J.gain = INP(I_KVN); J.dst = (unsigned char*)P_WKV; J.ld = KVW; J.K = D; J.type = CT_WKV; J.fp8 = 0; conv_job_tile(J, t_, KVW / 64); } \
                            else { J.src = INP(I_BWIN); J.gain = INP(I_ATN) + D; J.dst = (unsigned char*)P_WIN; J.ld = B_IN; J.K = D; J.type = CT_WINB; J.fp8 = 0; conv_job_tile(J, t_ - T_KV, B_IN / 64); } } \
                        else if ((t_ -= t_in) < T_WO) { J.src = INP(I_WOUT) + (size_t)L * D * D; J.gain = nullptr; J.dst = (unsigned char*)P_WOUT; J.ld = D; J.K = D; J.type = CT_ID; J.fp8 = 0; conv_job_tile(J, t_, D / 64); } \
                        else if ((t_ -= T_WO) < T_GU) { J.src = INP(I_F2GU) + (size_t)L * D * NGU; J.gain = INP(I_F2N) + (size_t)L * D; J.dst = (unsigned char*)P_WGU(1); J.ld = NGU; J.K = D; J.type = CT_GU; J.fp8 = (FP8_MASK >> (2 * L + 1)) & 1; conv_job_tile(J, t_, NGU / 64); } \
                        else { t_ -= T_GU; J.src = INP(I_F2DN) + (size_t)L * FF * D; J.gain = nullptr; J.dst = (unsigned char*)P_WDN(1); J.ld = D; J.K = FF; J.type = CT_ID; J.fp8 = (DN8_MASK >> (2 * L + 1)) & 1; conv_job_tile(J, t_, D / 64); } }
                    ConvJob ja, jb; f32x4 va[8], vb[8], ga[2], gb[2];
                    { CONV_PICK(ja, min(bid, total - 1)) conv_load(ja, va, ga, kg, nq, zf); }
                    for (int t = bid; t < total; t += 2 * G) {
                        { CONV_PICK(jb, min(t + G, total - 1)) conv_load(jb, vb, gb, kg, nq, zf); }
                        conv_store(ja, va, ga, kg, nq);
                        { CONV_PICK(ja, min(t + 2 * G, total - 1)) conv_load(ja, va, ga, kg, nq, zf); }
                        if (t + G < total) conv_store(jb, vb, gb, kg, nq);
                    }
#undef CONV_PICK
                }
}

__global__ void __launch_bounds__(NTHREADS, 2) fwd(Args a_unused) {
    extern __shared__ __attribute__((aligned(16))) unsigned char lds_raw[];
    LAS unsigned char* lds = (LAS unsigned char*)lds_raw;
    const int bid0 = blockIdx.x, G0 = gridDim.x;
    volatile LAS unsigned* misc = (volatile LAS unsigned*)(lds + STAGE_LDS);
    if (threadIdx.x < 4) misc[threadIdx.x] = 0u;
    __syncthreads();
    const int wave_s = __builtin_amdgcn_readfirstlane(threadIdx.x >> 6);
    int lo, hi;
    XcdBarrier bar;
    {
        const CAS char* kp = (const CAS char*)__builtin_amdgcn_kernarg_segment_ptr();
        lo = *(const CAS int*)(kp + 168); hi = *(const CAS int*)(kp + 172);
        unsigned* bw = (unsigned*)(*(unsigned char* const CAS*)(kp + 160) + WS_CTL);
        bar.bar = bw; bar.x = 0; bar.st = misc;
        if (hi - lo > 1) bar = xcd_barrier_post(bw, misc);
    }
    int pid = 0, sidx = 0;
#define IN_PHASE (pid >= lo && pid < hi)
#define END_PHASE do { if (pid >= lo && pid + 1 < hi) for (int rb_ = 0; rb_ < REP_BAR; ++rb_) xcd_barrier(bar); ++pid; } while (0)
#define PV int bid = bid0, G = G0; asm volatile("" : "+s"(bid), "+s"(G)); const int W = G * NWAVES, GT = G * NTHREADS; (void)W; (void)GT; int lane_o; asm volatile("v_mbcnt_lo_u32_b32 %0, -1, 0\n\tv_mbcnt_hi_u32_b32 %0, -1, %0" : "=v"(lane_o)); const int lane = lane_o, wave = wave_s, tid = wave * 64 + lane, gw = bid * NWAVES + wave, gtid = bid * NTHREADS + tid; \
    (void)lane; (void)gw; (void)gtid; (void)wave; \
    const CAS char* kp = (const CAS char*)__builtin_amdgcn_kernarg_segment_ptr(); asm volatile("" : "+s"(kp)); \
    unsigned char* const ws = *(unsigned char* const CAS*)(kp + 160); float* const X = *(float* const CAS*)(kp + 152); (void)ws; (void)X;

    for (int rall_ = 0; rall_ < REP_ALL; ++rall_) {
    if (rall_ > 0) { xcd_barrier(bar); pid = 0; sidx = 0; }
    for (int f = 0; f < 4; ++f) {
        const int L = f >> 1; const bool first = (f & 1) == 0;
        if (first) {
            if (IN_PHASE) for (int rep_ = 0; rep_ < REP_CONV; ++rep_) { PV
#ifdef PROBE_STREAM
                if (L == 0) {
                    f32x4 acc4 = {0.f, 0.f, 0.f, 0.f};
                    for (int w_ = 0; w_ < 4; ++w_) {
                        const f32x4* p4 = (const f32x4*)(w_ == 0 ? INP(I_F1GU) : w_ == 1 ? INP(I_F2GU) : w_ == 2 ? INP(I_F1DN) : INP(I_F2DN));
                        const int n4 = (w_ < 2 ? 2 * D * NGU : 2 * FF * D) / 4;
                        for (int e = gtid; e < n4; e += 8 * GT) {
                            f32x4 t_[8];
#pragma unroll
                            for (int u = 0; u < 8; ++u) t_[u] = e + u * GT < n4 ? p4[e + u * GT] : acc4;
#pragma unroll
                            for (int u = 0; u < 8; ++u) acc4 += t_[u];
                        }
                    }
                    if (acc4[0] + acc4[1] + acc4[2] + acc4[3] == 1.2345e33f) P_COS[gtid] = 1.f;
                }
#endif
                if (L == 0) {
                    const int* pos = (const int*)INP(I_POS); float* cs = P_COS; float* sn = P_SIN;
                    for (int e = gtid; e < S * 64; e += GT) {
                        const int t = e >> 6, i = e & 63;
                        const float inv = exp2f(-(float)i * (13.287712379549449f / 64.0f));
                        const float ang = (float)pos[t] * inv;
                        double rev = (double)ang * 0.15915494309189535; rev -= __builtin_rint(rev);
                        const float rf = (float)rev;
                        cs[e] = __builtin_amdgcn_cosf(rf); sn[e] = __builtin_amdgcn_sinf(rf);
                    }
                    xcopy_rows(INP(I_X), P_H, (FP8_MASK & 1) ? P_H8 : nullptr, P_SS(0), gw, W, lane);
#if !MEMKV_IN_PROJ
                    if (bid & 1) for (int unit = bid; unit < 256; unit += G) memkv_unit(unit, INP(I_MEM), INP(I_MEMN), INP(I_WMKV), P_MEMK, P_MEMVT, (LAS float*)lds, tid);
#endif
                }
                conv_layer(kp, ws, L, bid, G, lane, wave);
#if !MEMKV_IN_PROJ
                if (L == 0 && !(bid & 1)) for (int unit = bid; unit < 256; unit += G) memkv_unit(unit, INP(I_MEM), INP(I_MEMN), INP(I_WMKV), P_MEMK, P_MEMVT, (LAS float*)lds, tid);
#endif
#ifdef PROBE_CONV2
                conv_layer(kp, ws, L, bid, G, lane, wave);
#endif
            }
            END_PHASE;
        }
        if (f == 2) {
            if (IN_PHASE) for (int rep_ = 0; rep_ < REP_PROJB; ++rep_) { PV
                pg8::Gemm g{P_H, P_WKV, S, KVW, D}; pg8::StaticOrder so; so.init(S, KVW, G, bid);
                RS_PREPASS(so, P_SS(sidx))
                EpiProj<2> E{P_Q, P_K, P_V, P_QI, P_KI, P_QM, P_WI, P_COS, P_SIN, INP(I_IKN), P_SS(sidx), RSL, rowbase};
                pg8::gemm_phase<EpiProj<2>, pg8::StaticOrder, false>(lds, g, so, E, nullptr, wave);
            }
            END_PHASE;
            if (IN_PHASE) for (int rep_ = 0; rep_ < REP_KVPOST; ++rep_) { PV for (int unit = bid; unit < 256; unit += G) kvpost_unit(unit, P_K, P_V, P_KMEAN, P_KBLK, P_VT, lds, tid); }
            END_PHASE;
        }
        if (IN_PHASE) for (int rep_ = 0; rep_ < REP_GU; ++rep_) { PV
            pg8::StaticOrder so; so.init(S, NGU, G, bid);
            RS_PREPASS(so, P_SS(sidx))
            if ((FP8_MASK >> f) & 1) {
                pg8::Gemm g{(const bf16_t*)P_H8, P_WGU(f & 1), S, NGU, D / 2};
#if DN8_MASK != FP8_MASK
                if (!((DN8_MASK >> f) & 1)) {
                    EpiSwiglu<true, false> E{P_ACT, P_SS(sidx), RSL, rowbase};
                    pg8::gemm_phase<EpiSwiglu<true, false>, pg8::StaticOrder, false, true>(lds, g, so, E, nullptr, wave);
                } else
#endif
                {
                    EpiSwiglu<true, true> E{P_ACT, P_SS(sidx), RSL, rowbase};
                    pg8::gemm_phase<EpiSwiglu<true, true>, pg8::StaticOrder, false, true>(lds, g, so, E, nullptr, wave);
                }
            } else {
                pg8::Gemm g{P_H, P_WGU(f & 1), S, NGU, D};
                EpiSwiglu<false> E{P_ACT, P_SS(sidx), RSL, rowbase};
                pg8::gemm_phase<EpiSwiglu<false>, pg8::StaticOrder, false, false>(lds, g, so, E, nullptr, wave);
            }
        }
        END_PHASE;
        if (IN_PHASE) { PV
            pg8::StaticOrder so; so.init(S, D, G, bid);
            if ((DN8_MASK >> f) & 1) {
                pg8::Gemm g{P_ACT, P_WDN(f & 1), S, D, FF / 2};
                EpiResid<1, true> E{P_H, (f == 1 && ((FP8_MASK >> 2) & 1)) ? P_H8 : nullptr, P_SS(sidx + 1)};
                pg8::gemm_phase<EpiResid<1, true>, pg8::StaticOrder, false, true>(lds, g, so, E, nullptr, wave);
            } else {
                pg8::Gemm g{P_ACT, P_WDN(f & 1), S, D, FF};
                EpiResid<1> E{P_H, (f == 1 && ((FP8_MASK >> 2) & 1)) ? P_H8 : nullptr, P_SS(sidx + 1)};
                pg8::gemm_phase<EpiResid<1>, pg8::StaticOrder, false>(lds, g, so, E, nullptr, wave);
            }
        }
        END_PHASE; ++sidx;
        if (!first) continue;
        if (L == 0) {
            if (IN_PHASE) for (int rep_ = 0; rep_ < REP_PROJ; ++rep_) { PV
                pg8::Gemm g{P_H, P_WIN, S, NPA, D}; pg8::StaticOrder so; so.init(S, NPA, G, bid);
                RS_PREPASS(so, P_SS(sidx))
                EpiProj<0> E{P_Q, P_K, P_V, P_QI, P_KI, P_QM, P_WI, P_COS, P_SIN, INP(I_IKN), P_SS(sidx), RSL, rowbase};
                pg8::gemm_phase<EpiProj<0>, pg8::StaticOrder, false>(lds, g, so, E, nullptr, wave);
#if MEMKV_IN_PROJ
                {
                    const int extra = ((S / pg8::BM) * (NPA / pg8::BM)) % G;
                    __syncthreads();
                    if (extra == 0) { for (int unit = bid; unit < 256; unit += G) memkv_unit(unit, INP(I_MEM), INP(I_MEMN), INP(I_WMKV), P_MEMK, P_MEMVT, (LAS float*)lds, tid); }
                    else if (bid >= extra) { for (int unit = bid - extra; unit < 256; unit += G - extra) memkv_unit(unit, INP(I_MEM), INP(I_MEMN), INP(I_WMKV), P_MEMK, P_MEMVT, (LAS float*)lds, tid); }
                }
#endif
            }
            END_PHASE;
#if IDXDSA_FUSED
            if (IN_PHASE) { PV
                volatile LAS int* flags = (volatile LAS int*)(lds + STAGE_LDS + 5120);
                if (tid < 4) flags[tid] = 0;
                __syncthreads();
                for (int item = gw; item < (S / 32) * NMH; item += W) memattn_item(item, 0, P_QM, P_MEMK, P_MEMVT, P_AO, lane);
                const int kw = wave & 3, pw = bid * 4 + kw, PW = G * 4;
                if (wave < 4) {
                    idx_phase(P_QI, P_KI, P_WI, P_SEL, P_NSEL, lds, tid, bid, G, pw, PW, lds + kw * (LCAP * 24), flags + kw);
                } else {
                    int seq = 0;
                    for (int i0 = pw; i0 < (S / 4) / 2; i0 += PW)
                        for (int rep = 0; rep < 2; ++rep) {
                            const int u = rep ? (S / 4 - 1 - i0) : i0;
                            while (flags[kw] <= seq) __builtin_amdgcn_s_sleep(8);
                            __builtin_amdgcn_fence(__ATOMIC_ACQUIRE, "workgroup");
                            for (int q = 0; q < 4; ++q)
                                dsa_query2(4 * u + q, 0, NKV, P_Q, (const unsigned char*)P_K, (const unsigned char*)P_V, P_SEL, P_NSEL, P_AO, lds + 4 * (LCAP * 24) + kw * 16384, lds + STAGE_LDS + 1024 + kw * 1024, lane);
                            ++seq;
                        }
                }
            }
            END_PHASE;
#else
            if (IN_PHASE) for (int rep_ = 0; rep_ < REP_IDX; ++rep_) { PV idx_phase(P_QI, P_KI, P_WI, P_SEL, P_NSEL, lds, tid, bid, G); }
#ifdef PROBE_IDX_MODE
            if (IN_PHASE) { PV idx_phase<PROBE_IDX_MODE>(P_QI, P_KI, P_WI, (unsigned short*)P_ACT, (int*)(P_ACT + (size_t)S * TOPK), lds, tid, bid, G); }
#endif
            END_PHASE;
            if (IN_PHASE) for (int rep_ = 0; rep_ < REP_DSA; ++rep_) { PV
                if (bid & 1) for (int item = gw; item < (S / 32) * NMH; item += W) memattn_item(item, 0, P_QM, P_MEMK, P_MEMVT, P_AO, lane);
#if DSA_MFMA == 2
                dsa_phase(P_Q, (const unsigned char*)P_K, (const unsigned char*)P_V, P_SEL, P_NSEL, P_AO, lds + wave * 16384, lds + STAGE_LDS + 1024 + wave * 1024, gw, W, lane);
#elif DSA_MFMA == 1
                for (int t = gw; t < S; t += W) dsa_query2(t, 0, NKV, P_Q, (const unsigned char*)P_K, (const unsigned char*)P_V, P_SEL, P_NSEL, P_AO, lds + wave * 16384, lds + STAGE_LDS + 1024 + wave * 1024, lane);
                if (!(bid & 1)) for (int item = gw; item < (S / 32) * NMH; item += W) memattn_item(item, 0, P_QM, P_MEMK, P_MEMVT, P_AO, lane);
#else
                for (int t = gw; t < S; t += W) dsa_query(t, 0, NKV, P_Q, (const unsigned char*)P_K, (const unsigned char*)P_V, P_SEL, P_NSEL, P_AO, lds + wave * 5120, lane);
#endif
            }
            END_PHASE;
#endif
        } else {
            if (IN_PHASE) for (int rep_ = 0; rep_ < REP_PROJB; ++rep_) { PV
                pg8::Gemm g{P_H, P_WIN, S, B_IN, D}; pg8::StaticOrder so; so.init(S, B_IN, G, bid);
                RS_PREPASS(so, P_SS(sidx))
                EpiProj<1> E{P_Q, P_K, P_V, P_QI, P_KI, P_QM, P_WI, P_COS, P_SIN, INP(I_IKN), P_SS(sidx), RSL, rowbase};
                pg8::gemm_phase<EpiProj<1>, pg8::StaticOrder, false>(lds, g, so, E, nullptr, wave);
            }
            END_PHASE;
            if (IN_PHASE) for (int rep_ = 0; rep_ < REP_M1; ++rep_) { PV for (int unit = bid; unit < 256; unit += G) moba_gate_unit(unit, P_Q, P_KMEAN, P_ITEMS, P_NITEMS, P_IB, lds, tid); }
            END_PHASE;
            if (IN_PHASE) for (int rep_ = 0; rep_ < REP_M2; ++rep_) { PV
                if (bid & 1) for (int item = gw; item < (S / 32) * NMH; item += W) memattn_item(item, 1, P_QM, P_MEMK, P_MEMVT, P_AOB, lane);
                moba_phase_lds(P_Q, P_KBLK, P_VT, P_ITEMS, P_IB, P_PO, P_PML, lds, tid, bid, G);
                if (!(bid & 1)) for (int item = gw; item < (S / 32) * NMH; item += W) memattn_item(item, 1, P_QM, P_MEMK, P_MEMVT, P_AOB, lane);
            }
            END_PHASE;
            if (IN_PHASE) for (int rep_ = 0; rep_ < REP_MERGE; ++rep_) { PV moba_merge(P_PO, P_PML, P_AOB, gtid, GT); }
            END_PHASE;
        }
        if (IN_PHASE) { PV
            pg8::Gemm g{L == 0 ? P_AO : P_AOB, P_WOUT, S, D, D}; pg8::StaticOrder so; so.init(S, D, G, bid);
            EpiResid<0> E{P_H, ((FP8_MASK >> (2 * L + 1)) & 1) ? P_H8 : nullptr, P_SS(sidx + 1)};
            pg8::gemm_phase<EpiResid<0>, pg8::StaticOrder, false>(lds, g, so, E, nullptr, wave);
        }
        END_PHASE; ++sidx;
    }
    if (rall_ + 1 < REP_ALL) {   } else
    if (IN_PHASE) { PV final_norm_rows(P_H, X, INP(I_FINN), P_SS(sidx), gw, W, lane); }
    END_PHASE;
    }
#undef IN_PHASE
#undef END_PHASE
}
constexpr int N_PHASES = 7 + 2 + 10 + 2 + 1 - (IDXDSA_FUSED ? 1 : 0);

extern "C" void kernel_launch(void* const* d_in, const int* in_sizes, int n_in, void* d_out, int out_size, void* d_ws, size_t ws_size, hipStream_t stream) {
    static int grid = 0;
    if (grid == 0) {
        if (n_in != 19 || out_size != S * D || ws_size < WS_END) { fprintf(stderr, "kernel_launch: unexpected shapes (n_in %d out %d ws %zu need %zu)\n", n_in, out_size, ws_size, (size_t)WS_END); grid = -1; return; }
        int dev = 0, cus = 0, per_cu = 0;
        if (hipGetDevice(&dev) != hipSuccess || hipDeviceGetAttribute(&cus, hipDeviceAttributeMultiprocessorCount, dev) != hipSuccess) { grid = -1; return; }
        if (hipFuncSetAttribute((const void*)fwd, hipFuncAttributeMaxDynamicSharedMemorySize, LDS_BYTES) != hipSuccess) { fprintf(stderr, "kernel_launch: hipFuncSetAttribute failed\n"); grid = -1; return; }
        if (hipOccupancyMaxActiveBlocksPerMultiprocessor(&per_cu, (const void*)fwd, NTHREADS, LDS_BYTES) != hipSuccess || per_cu < 1) { fprintf(stderr, "kernel_launch: occupancy query says %d\n", per_cu); (void)hipGetLastError(); grid = -1; return; }
        grid = cus;
    }
    if (grid < 0) return;
    (void)hipMemsetAsync((char*)d_ws + WS_CTL, 0, ZERO_BYTES, stream);
    Args a{};
    for (int i = 0; i < 19; ++i) a.in[i] = (const float*)d_in[i];
    a.out = (float*)d_out; a.ws = (unsigned char*)d_ws;
#if MK_ONE_LAUNCH
    a.ph_lo = 0; a.ph_hi = N_PHASES;
    hipLaunchKernelGGL(fwd, dim3(grid), dim3(NTHREADS), LDS_BYTES, stream, a);
#else
    for (int p = 0; p < N_PHASES; ++p) { a.ph_lo = p; a.ph_hi = p + 1; hipLaunchKernelGGL(fwd, dim3(grid), dim3(NTHREADS), LDS_BYTES, stream, a); }
#endif
}
```

```cpp
#include <hip/hip_runtime.h>
#include <cstdio>
#include <cstdint>

#define LAS __attribute__((address_space(3)))
#define DI __device__ __forceinline__

constexpr int S = 16384, D = 2048, FF = 5632, NGU = 2 * FF;
constexpr int NH = 12, NKV = 4, NMH = 4, HD = 128, NMEM = 256, IH = 16, ID = 64, TOPK = 256, MBLK = 256, NBLK = S / MBLK;
constexpr int A_IN = 4176, NPA = 4352, B_IN = 2048, KVW = 1024;
constexpr float RMS_EPS = 1e-6f;
constexpr float ATT_SC = 0.08838834764831845f * 1.4426950408889634f;
constexpr float W8_SCALE = 64.0f; constexpr int W8_E8M0 = 0x79797979;
constexpr float ACT8_SCALE = 8.0f;
constexpr float IDX_W_SCALE = 0.25f * 0.125f;
constexpr int NWAVES = 8, NTHREADS = 512;
constexpr int STAGE_LDS = 131072, MISC_LDS = 10240, LDS_BYTES = STAGE_LDS + MISC_LDS;

typedef unsigned short bf16_t;
typedef short bf16x8 __attribute__((ext_vector_type(8)));
typedef float f32x4 __attribute__((ext_vector_type(4)));
typedef float f32x2 __attribute__((ext_vector_type(2)));
typedef float f32x16 __attribute__((ext_vector_type(16)));
typedef unsigned u32x4 __attribute__((ext_vector_type(4)));
typedef unsigned u32x2 __attribute__((ext_vector_type(2)));
typedef __bf16 bf16v2_t __attribute__((ext_vector_type(2)));

DI unsigned pk_bf16(float a, float b) { f32x2 f = {a, b}; bf16v2_t r = __builtin_convertvector(f, bf16v2_t); return __builtin_bit_cast(unsigned, r); }
DI float bf_lo(unsigned u) { return __uint_as_float(u << 16); }
DI float bf_hi(unsigned u) { return __uint_as_float(u & 0xffff0000u); }
DI float shx(float v, int k, int lane) { return __int_as_float(__builtin_amdgcn_ds_bpermute((lane ^ k) << 2, __float_as_int(v))); }
DI unsigned shxu(unsigned v, int k, int lane) { return (unsigned)__builtin_amdgcn_ds_bpermute((lane ^ k) << 2, (int)v); }
DI float wave_sum(float v, int lane) { v += shx(v, 32, lane); v += shx(v, 16, lane); v += shx(v, 8, lane); v += shx(v, 4, lane); v += shx(v, 2, lane); v += shx(v, 1, lane); return v; }
DI void lds_fence() { asm volatile("s_waitcnt lgkmcnt(0)" ::: "memory"); }
DI int rope128_src(int p) { return ((p >> 2) & 1) * 64 + 4 * (p >> 3) + (p & 3); }
DI int rope64_src(int p) { return ((p >> 2) & 1) * 32 + 4 * (p >> 3) + (p & 3); }
DI int kblk_off(int key, int d) { return (((key >> 5) * 8 + (d >> 4)) * 64 + ((d >> 3) & 1) * 32 + (key & 31)) * 8 + (d & 7); }
DI int vt_pos(int key) { return (key & ~12) | ((key & 8) >> 1) | ((key & 4) << 1); }

DI int vtblk_off(int key, int d) { const int pos = vt_pos(key); return ((((d >> 5) * 8 + (pos >> 5)) * 2 + ((pos >> 4) & 1)) * 64 + ((pos >> 3) & 1) * 32 + (d & 31)) * 8 + (pos & 7); }

constexpr size_t AL(size_t x) { return (x + 255) & ~(size_t)255; }
constexpr size_t WS_CTL = 0, CTL_BYTES = 65536;
constexpr size_t ZERO_BYTES = CTL_BYTES;
constexpr size_t WS_ROPE = WS_CTL + CTL_BYTES;
constexpr size_t WS_WGU0 = WS_ROPE + (size_t)S * 64 * 4 * 2;
constexpr size_t WS_WDN0 = WS_WGU0 + (size_t)NGU * D * 2;
constexpr size_t WS_WGU1 = WS_WDN0 + (size_t)D * FF * 2;
constexpr size_t WS_WDN1 = WS_WGU1 + (size_t)NGU * D * 2;
constexpr size_t WS_WIN = WS_WDN1 + (size_t)D * FF * 2;
constexpr size_t WS_WOUT = WS_WIN + (size_t)NPA * D * 2;
constexpr size_t WS_WKV = WS_WOUT + (size_t)D * D * 2;
constexpr size_t WS_H = WS_WKV + (size_t)KVW * D * 2;
constexpr size_t WS_ACT = WS_H + (size_t)S * D * 2;
constexpr size_t WS_AO = WS_ACT + (size_t)S * FF * 2;
constexpr size_t WS_Q = WS_AO + (size_t)S * D * 2;
constexpr size_t WS_K = WS_Q + (size_t)S * NH * HD * 2;
constexpr size_t WS_V = WS_K + (size_t)S * NKV * HD * 2;
constexpr size_t WS_QI = WS_V + (size_t)S * NKV * HD * 2;
constexpr size_t WS_KI = WS_QI + (size_t)S * IH * ID * 2;
constexpr size_t WS_WI = WS_KI + (size_t)S * ID * 2;
constexpr size_t WS_QM = WS_WI + (size_t)S * IH * 4;
constexpr size_t WS_SEL = WS_QM + (size_t)S * NMH * HD * 2;
constexpr size_t WS_NSEL = WS_SEL + (size_t)S * TOPK * 2;
constexpr size_t WS_MEMK = WS_NSEL + (size_t)S * 4;
constexpr size_t WS_MEMVT = WS_MEMK + (size_t)2 * NMH * NMEM * HD * 2;
constexpr size_t WS_KMEAN = WS_MEMVT + (size_t)2 * NMH * NMEM * HD * 2;
constexpr size_t WS_ITEMS = WS_KMEAN + (size_t)NKV * NBLK * HD * 4;
constexpr int ITEM_CAP = 136, ITEM_U16 = 48, OWN_ITEMS = 24, SLOTS_PER_UNIT = ITEM_CAP + OWN_ITEMS;
constexpr size_t WS_NITEMS = WS_ITEMS + (size_t)256 * ITEM_CAP * ITEM_U16 * 2;
constexpr size_t WS_IB = WS_NITEMS + 1024;
constexpr size_t WS_PML = WS_IB + (size_t)256 * 68 * 4;
constexpr size_t WS_SS = WS_PML + (size_t)S * NH * 4 * 2 * 4;
constexpr size_t WS_H8 = WS_SS + (size_t)7 * S * 32 * 4;
constexpr size_t WS_END = WS_H8 + (size_t)S * D;
constexpr size_t WS_PO = WS_ACT;
static_assert((size_t)S * NH * 4 * HD * 2 <= (WS_Q - WS_ACT), "MoBA partials must fit in ACT+AO");
static_assert(WS_END < (size_t)760 * 1024 * 1024, "workspace budget");
#define XB_TMO      128
#define XB_XCNT(j)  (256  + 64 * (j))
#define XB_XSUB(j)  (1280 + 64 * (j))
#define XB_XGEN(j)  (2304 + 64 * (j))
#define XB_TOP      3328
#define XB_TOPGEN   3392
#define XCD_BAR_WORDS 3456
#define XB_SPIN_CAP (1u << 18)

__device__ __forceinline__ unsigned xb_ld(unsigned* p)              { unsigned long long a = (unsigned long long)p; asm volatile("" : "+v"(a)); return __hip_atomic_load((unsigned*)a, __ATOMIC_RELAXED, __HIP_MEMORY_SCOPE_AGENT); }
__device__ __forceinline__ unsigned xb_add(unsigned* p, unsigned v) { unsigned long long a = (unsigned long long)p; asm volatile("" : "+v"(a), "+v"(v)); return __hip_atomic_fetch_add((unsigned*)a, v, __ATOMIC_RELAXED, __HIP_MEMORY_SCOPE_AGENT); }
__device__ __forceinline__ unsigned xb_xcc_id() { return (unsigned)__builtin_amdgcn_s_getreg((3 << 11) | 20) & 0xFu; }
#define XB_SPIN(cond, bar) do { unsigned _sp = 0; while (cond) { __builtin_amdgcn_s_sleep(1); \
    if ((++_sp & 255u) == 0u) { if (xb_ld(&(bar)[XB_TMO])) break; if (_sp > XB_SPIN_CAP) { (void)xb_add(&(bar)[XB_TMO], 1u); break; } } } } while (0)

struct XcdBarrier {
    unsigned* bar; unsigned x;
    volatile LAS unsigned* st;
};

__device__ __forceinline__ XcdBarrier xcd_barrier_post(unsigned* bar, volatile LAS unsigned* st) {
    XcdBarrier b; b.bar = bar; b.x = xb_xcc_id(); b.st = st;
    if (threadIdx.x == 0) (void)xb_add(&bar[XB_XCNT(b.x)], 1u);
    return b;
}
__device__ __forceinline__ void xcd_barrier_complete(unsigned* bar, unsigned x, unsigned& nloc, unsigned& nx) {
    const unsigned G = gridDim.x * gridDim.y * gridDim.z;
    unsigned sum, cnt, mine, sp = 0u;
    for (;;) {
        sum = 0u; cnt = 0u; mine = 0u;
#pragma unroll
        for (unsigned j = 0; j < 16; ++j) { const unsigned c = xb_ld(&bar[XB_XCNT(j)]); sum += c; cnt += (c > 0u) ? 1u : 0u; mine = (j == x) ? c : mine; }
        if (sum == G) break;
        __builtin_amdgcn_s_sleep(1);
        if ((++sp & 255u) == 0u) { if (xb_ld(&bar[XB_TMO])) break; if (sp > XB_SPIN_CAP) { (void)xb_add(&bar[XB_TMO], 1u); break; } }
    }
    nloc = mine > 0u ? mine : 1u; nx = cnt > 0u ? cnt : 1u;
}

__device__ __forceinline__ void xcd_barrier(const XcdBarrier& b) {
    asm volatile("s_waitcnt vmcnt(0)" ::: "memory");
    __syncthreads();
    if (threadIdx.x == 0) {
        unsigned* bar = b.bar;
        __builtin_amdgcn_s_waitcnt(0);
        unsigned nloc = b.st[0], nx = b.st[1];
        if (nloc == 0u) { xcd_barrier_complete(bar, b.x, nloc, nx); b.st[0] = nloc; b.st[1] = nx; }
        const unsigned old = xb_add(&bar[XB_XSUB(b.x)], 1u);
        const unsigned gen = old / nloc;
        if (old + 1u == (gen + 1u) * nloc) {
            __builtin_amdgcn_fence(__ATOMIC_RELEASE, "agent");
            asm volatile("s_waitcnt vmcnt(0)" ::: "memory");
            const unsigned og = xb_add(&bar[XB_TOP], 1u);
            const unsigned tg = og / nx;
            if (og + 1u == (tg + 1u) * nx) xb_add(&bar[XB_TOPGEN], 1u);
            else XB_SPIN(xb_ld(&bar[XB_TOPGEN]) == tg, bar);
            __builtin_amdgcn_fence(__ATOMIC_ACQUIRE, "agent");
            xb_add(&bar[XB_XGEN(b.x)], 1u);
            asm volatile("s_waitcnt vmcnt(0)" ::: "memory");
        } else {
            XB_SPIN(xb_ld(&bar[XB_XGEN(b.x)]) == gen, bar);
            __builtin_amdgcn_fence(__ATOMIC_ACQUIRE, "agent");
            asm volatile("s_waitcnt vmcnt(0)" ::: "memory");
        }
    }
    __syncthreads();
}

namespace pg8 {
#define PG8_LAS __attribute__((address_space(3)))
typedef unsigned short bf16_t;
typedef short bf16x8 __attribute__((ext_vector_type(8)));
typedef float f32x4 __attribute__((ext_vector_type(4)));
typedef unsigned u32x4 __attribute__((ext_vector_type(4)));
constexpr int BM = 256, BK = 64, HALF = 128, HTB = HALF * BK * 2  , STAGE_BYTES = 8 * HTB, NXCD = 8, WGM = 8;

__host__ __device__ __forceinline__ int lds_byte(int r, int c) { const int st = (r >> 4) * 2 + (c >> 5), rr = r & 15, cc = c & 31, ob = rr * 64 + cc * 2; return st * 1024 + (ob ^ (((ob >> 9) & 1) << 5)); }
__host__ __device__ __forceinline__ void stage_rc(int b, int& R, int& C) { const int st = b / 1024, sb = b % 1024, swz = sb ^ (((sb >> 9) & 1) << 5); R = (st >> 1) * 16 + swz / 64; C = (st & 1) * 32 + (swz % 64) / 2; }
__host__ __device__ __forceinline__ int perm32(int rho) { const int n = rho >> 4, i = rho & 15; return 8 * (i >> 2) + 4 * n + (i & 3); }

struct Unit { int pm, pn; };
struct Gemm { const bf16_t* A; const bf16_t* Bt; int M, N, K; };

struct StaticOrder {
    int nM, nN, nwg, G, c;
    __host__ __device__ void init(int M, int N, int G_, int c_) { nM = M / BM; nN = N / BM; nwg = nM * nN; G = G_; c = c_; }
    __host__ __device__ __forceinline__ bool next(int i, Unit& u) const {
        const int L = i * G + c; if (L >= nwg) return false;
        int wgid = (int)L; { const int q = nwg / NXCD, r = nwg % NXCD, xcd = wgid % NXCD, off = wgid / NXCD; wgid = (xcd < r ? xcd * (q + 1) : r * (q + 1) + (xcd - r) * q) + off; }
        const int nig = WGM * nN, gid = wgid / nig, fm = gid * WGM, gsz = (nM - fm) < WGM ? (nM - fm) : WGM;
        u.pm = fm + ((wgid % nig) % gsz); u.pn = (wgid % nig) / gsz; return true;
    }
    __device__ __forceinline__ void a_ready(const Unit&) const {}
    __device__ __forceinline__ void done(const Unit&) const {}
};
__device__ __forceinline__ unsigned cvt_pk_bf16(float lo, float hi) { return pk_bf16(lo, hi); }

#ifndef PG8_EPI_TWICE
#define PG8_EPI_TWICE 0
#endif
template <class Epi, class Sched, bool STAMP = false, bool FP8 = false, int SCALE_W = 0x7F7F7F7F>
__device__ __forceinline__ void gemm_phase(PG8_LAS unsigned char* lds, const Gemm g, const Sched& S, const Epi& E, unsigned long long* stamps, int wave_in) {
    int tid_o; asm volatile("v_mbcnt_lo_u32_b32 %0, -1, 0\n\tv_mbcnt_hi_u32_b32 %0, -1, %0" : "=v"(tid_o)); tid_o += wave_in * 64;
    const int tid = tid_o, wid = __builtin_amdgcn_readfirstlane(tid >> 6), lane = tid & 63, wr = wid >> 2, wc = wid & 3, fr = lane & 15, fq = lane >> 4;
    const int K = g.K, nt = K / BK;
    int ts_lo = 0, ts_hi = 0, nts = 0; const unsigned long long rt_entry = STAMP ? (unsigned long long)wall_clock64() : 0ull;
#define PG8_STAMP() do { if (STAMP && wid == 0 && nts < 64) { const unsigned long long _c = (unsigned long long)clock64(); \
        ts_lo = (lane == nts) ? (int)(unsigned)_c : ts_lo; ts_hi = (lane == nts) ? (int)(unsigned)(_c >> 32) : ts_hi; ++nts; } } while (0)
    PG8_STAMP();
    unsigned voffA[2], voffB[2];
#pragma unroll
    for (int i = 0; i < 2; ++i) { int R, C; stage_rc(tid * 16 + i * 8192, R, C); const int Rb = Epi::PERM ? ((R & ~31) + perm32(R & 31)) : R;
        voffA[i] = (unsigned)(R * K + C) * 2u; voffB[i] = (unsigned)(Rb * K + C) * 2u; }
    const size_t kstep = (size_t)(BK * 2);
    const size_t hstep = (size_t)HALF * K * 2;
    const size_t tstep = 2 * hstep;
    const unsigned ldsw = (unsigned)wid * 1024u;
    const int aoff = lds_byte(wr * 64 + fr, fq * 8), boff = lds_byte(wc * 32 + fr, fq * 8);
#define PG8_SA(b, h) (((b) * 2 + (h)) * HTB)
#define PG8_SB(b, h) ((4 + (b) * 2 + (h)) * HTB)
#define PG8_STAGE(bufoff, gbase, voff) do { const unsigned long long gb64_ = (unsigned long long)(gbase); \
        const unsigned long long gbu_ = ((unsigned long long)(unsigned)__builtin_amdgcn_readfirstlane((int)(gb64_ >> 32)) << 32) | (unsigned)__builtin_amdgcn_readfirstlane((int)gb64_); \
        _Pragma("unroll") for (int _i = 0; _i < 2; ++_i) { unsigned keep_; const unsigned ldsd_ = (unsigned)(unsigned long long)(lds + (bufoff) + ldsw + _i * 8192); \
            asm volatile("s_mov_b32 %0, m0\n\ts_mov_b32 m0, %3\n\ts_nop 0\n\tglobal_load_lds_dwordx4 %1, %2\n\ts_mov_b32 m0, %0" : "=&s"(keep_) : "v"((voff)[_i]), "s"(gbu_), "s"(ldsd_) : "memory"); } } while (0)
#define PG8_LDA(dst, b, h) do { _Pragma("unroll") for (int m = 0; m < 4; ++m) _Pragma("unroll") for (int k = 0; k < 2; ++k) dst[m][k] = *(const PG8_LAS bf16x8*)(lds + PG8_SA(b, h) + aoff + m * 2048 + k * 1024); } while (0)
#define PG8_LDB(dst, b, h) do { _Pragma("unroll") for (int n = 0; n < 2; ++n) _Pragma("unroll") for (int k = 0; k < 2; ++k) dst[n][k] = *(const PG8_LAS bf16x8*)(lds + PG8_SB(b, h) + boff + n * 2048 + k * 1024); } while (0)
typedef int pg8_i32x8 __attribute__((ext_vector_type(8)));
#define PG8_CAT8(x, y) (__builtin_shufflevector(__builtin_bit_cast(u32x4, (x)), __builtin_bit_cast(u32x4, (y)), 0, 1, 2, 3, 4, 5, 6, 7))
#define PG8_MMA(ai, bj, At, Bt) do { __builtin_amdgcn_s_setprio(1); _Pragma("unroll") for (int m = 0; m < 4; ++m) _Pragma("unroll") for (int n = 0; n < 2; ++n) { \
        if constexpr (FP8) { const pg8_i32x8 b8_ = __builtin_bit_cast(pg8_i32x8, PG8_CAT8(Bt[n][0], Bt[n][1])), a8_ = __builtin_bit_cast(pg8_i32x8, PG8_CAT8(At[m][0], At[m][1])); \
            asm("v_mfma_f32_16x16x128_f8f6f4 %0, %1, %2, %0" : "+v"(acc[ai][bj][m][n]) : "v"(b8_), "v"(a8_)); }   \
        else { _Pragma("unroll") for (int k = 0; k < 2; ++k) acc[ai][bj][m][n] = __builtin_amdgcn_mfma_f32_16x16x32_bf16(Bt[n][k], At[m][k], acc[ai][bj][m][n], 0, 0, 0); } } \
        __builtin_amdgcn_s_setprio(0); } while (0)
#define PG8_WAIT_V(n) asm volatile("s_waitcnt vmcnt(" #n ")" ::: "memory")
#define PG8_WAIT_L(n) asm volatile("s_waitcnt lgkmcnt(" #n ")" ::: "memory")
#define PG8_BAR __builtin_amdgcn_s_barrier()
#define PG8_SCHED __builtin_amdgcn_sched_barrier(0)
    Unit cur, nxt; int ui = 0;
    if (!S.next(0, cur)) return;
    f32x4 acc[2][2][4][2];
#pragma unroll
    for (int a = 0; a < 2; ++a)
#pragma unroll
        for (int b = 0; b < 2; ++b)
#pragma unroll
            for (int m = 0; m < 4; ++m)
#pragma unroll
                for (int n = 0; n < 2; ++n) acc[a][b][m][n] = (f32x4){0.f, 0.f, 0.f, 0.f};
    bf16x8 At[4][2], B0[2][2], B1[2][2];
    const char* cA = (const char*)g.A + (size_t)cur.pm * tstep; const char* cB = (const char*)g.Bt + (size_t)cur.pn * tstep;
    S.a_ready(cur);
    PG8_STAGE(PG8_SB(0, 0), cB, voffB); PG8_STAGE(PG8_SA(0, 0), cA, voffA); PG8_STAGE(PG8_SB(0, 1), cB + hstep, voffB); PG8_STAGE(PG8_SA(0, 1), cA + hstep, voffA);
    if (wr == 1) PG8_BAR;
    PG8_WAIT_V(4); PG8_BAR;
    PG8_STAGE(PG8_SB(1, 0), cB + kstep, voffB); PG8_STAGE(PG8_SA(1, 0), cA + kstep, voffA); PG8_STAGE(PG8_SB(1, 1), cB + hstep + kstep, voffB);
    PG8_WAIT_V(6); PG8_BAR;
    PG8_STAMP();
    for (;;) {
        const bool has_next = S.next(ui + 1, nxt);
        const char* nA = has_next ? (const char*)g.A + (size_t)nxt.pm * tstep : cA; const char* nB = has_next ? (const char*)g.Bt + (size_t)nxt.pn * tstep : cB;
        for (int t = 0; t < nt; t += 2) {
            const bool last = (t == nt - 2);
            const char* a1 = cA + (size_t)(t + 1) * kstep;
            const char* a2 = last ? nA : cA + (size_t)(t + 2) * kstep; const char* b2 = last ? nB : cB + (size_t)(t + 2) * kstep;
            const char* a3 = a2 + kstep; const char* b3 = b2 + kstep;
            if (last && has_next) S.a_ready(nxt);
            PG8_LDB(B0, 0, 0); PG8_SCHED; PG8_LDA(At, 0, 0); PG8_STAGE(PG8_SA(1, 1), a1 + hstep, voffA);
            PG8_WAIT_L(8); PG8_BAR; PG8_WAIT_L(0); PG8_MMA(0, 0, At, B0); PG8_BAR; PG8_SCHED;
            PG8_LDB(B1, 0, 1); PG8_STAGE(PG8_SB(0, 0), b2, voffB);
            PG8_BAR; PG8_WAIT_L(0); PG8_MMA(0, 1, At, B1); PG8_BAR;
            PG8_LDA(At, 0, 1); PG8_STAGE(PG8_SA(0, 0), a2, voffA);
            PG8_BAR; PG8_WAIT_L(0); PG8_MMA(1, 0, At, B0); PG8_BAR; PG8_SCHED;
            PG8_STAGE(PG8_SB(0, 1), b2 + hstep, voffB);
            PG8_WAIT_V(6); PG8_BAR; PG8_MMA(1, 1, At, B1); PG8_BAR;
            PG8_LDB(B0, 1, 0); PG8_SCHED; PG8_LDA(At, 1, 0); PG8_STAGE(PG8_SA(0, 1), a2 + hstep, voffA);
            PG8_WAIT_L(8); PG8_BAR; PG8_WAIT_L(0); PG8_MMA(0, 0, At, B0); PG8_BAR; PG8_SCHED;
            PG8_LDB(B1, 1, 1); PG8_STAGE(PG8_SB(1, 0), b3, voffB);
            PG8_BAR; PG8_WAIT_L(0); PG8_MMA(0, 1, At, B1); PG8_BAR;
            PG8_LDA(At, 1, 1); PG8_STAGE(PG8_SA(1, 0), a3, voffA);
            PG8_BAR; PG8_WAIT_L(0); PG8_MMA(1, 0, At, B0); PG8_BAR; PG8_SCHED;
            PG8_STAGE(PG8_SB(1, 1), b3 + hstep, voffB);
            PG8_WAIT_V(6); PG8_BAR; PG8_MMA(1, 1, At, B1); PG8_BAR;
        }
        PG8_STAMP();
        if constexpr (!Epi::AFTER_DRAIN) { { if constexpr (FP8) {
#define PG8_PAD(ai) asm volatile("s_nop 15\n\ts_nop 15" : "+v"(acc[ai][0][0][0]), "+v"(acc[ai][0][0][1]), "+v"(acc[ai][0][1][0]), "+v"(acc[ai][0][1][1]), "+v"(acc[ai][0][2][0]), "+v"(acc[ai][0][2][1]), "+v"(acc[ai][0][3][0]), "+v"(acc[ai][0][3][1]), \
                "+v"(acc[ai][1][0][0]), "+v"(acc[ai][1][0][1]), "+v"(acc[ai][1][1][0]), "+v"(acc[ai][1][1][1]), "+v"(acc[ai][1][2][0]), "+v"(acc[ai][1][2][1]), "+v"(acc[ai][1][3][0]), "+v"(acc[ai][1][3][1]))
              PG8_PAD(0); PG8_PAD(1);
#undef PG8_PAD
          }
          int ln_; asm volatile("v_mbcnt_lo_u32_b32 %0, -1, 0\n\tv_mbcnt_hi_u32_b32 %0, -1, %0" : "=v"(ln_)); E(acc, cur, wr, wc, ln_ & 15, ln_ >> 4); if (PG8_EPI_TWICE && Epi::PROBE2) { int l2_; asm volatile("v_mbcnt_lo_u32_b32 %0, -1, 0\n\tv_mbcnt_hi_u32_b32 %0, -1, %0" : "=v"(l2_)); E(acc, cur, wr, wc, l2_ & 15, l2_ >> 4); } }     S.done(cur); }
        PG8_STAMP();
        if (!has_next) break;
#pragma unroll
        for (int a = 0; a < 2; ++a)
#pragma unroll
            for (int b = 0; b < 2; ++b)
#pragma unroll
                for (int m = 0; m < 4; ++m)
#pragma unroll
                    for (int n = 0; n < 2; ++n) acc[a][b][m][n] = (f32x4){0.f, 0.f, 0.f, 0.f};
        cur = nxt; cA = nA; cB = nB; ++ui;
    }
    PG8_WAIT_V(0);
    if (wr == 0) PG8_BAR;
    PG8_BAR;
    if constexpr (Epi::AFTER_DRAIN) { E.fused(acc, cur, wr, wc, fr, fq, lds, wid, lane); S.done(cur); }
    PG8_STAMP();
    if (STAMP && wid == 0) { stamps[lane] = lane < nts ? (((unsigned long long)(unsigned)ts_hi << 32) | (unsigned)ts_lo) : 0ull;
        if (lane == 62) stamps[62] = rt_entry; if (lane == 63) stamps[63] = (unsigned long long)wall_clock64(); }
#undef PG8_STAMP
#undef PG8_SA
#undef PG8_SB
#undef PG8_STAGE
#undef PG8_LDA
#undef PG8_LDB
#undef PG8_MMA
#undef PG8_CAT8
#undef PG8_WAIT_V
#undef PG8_WAIT_L
#undef PG8_BAR
#undef PG8_SCHED
}
}
using pg8::Unit;
constexpr int BM = pg8::BM, HALF = pg8::HALF;

DI u32x4 pack8(const f32x4 a, const f32x4 b) { u32x4 w; w.x = pk_bf16(a[0], a[1]); w.y = pk_bf16(a[2], a[3]); w.z = pk_bf16(b[0], b[1]); w.w = pk_bf16(b[2], b[3]); return w; }
DI u32x2 pack8_fp8(const f32x4 a, const f32x4 b) {
    int w0 = 0, w1 = 0;
    w0 = __builtin_amdgcn_cvt_pk_fp8_f32(a[0], a[1], w0, false); w0 = __builtin_amdgcn_cvt_pk_fp8_f32(a[2], a[3], w0, true);
    w1 = __builtin_amdgcn_cvt_pk_fp8_f32(b[0], b[1], w1, false); w1 = __builtin_amdgcn_cvt_pk_fp8_f32(b[2], b[3], w1, true);
    u32x2 r; r.x = (unsigned)w0; r.y = (unsigned)w1; return r;
}
DI float silu_mul(float g, float u) { return g * __builtin_amdgcn_rcpf(1.0f + __builtin_amdgcn_exp2f(-1.4426950408889634f * g)) * u; }

DI void row_rs8(const float* SS, int row0, int fq, int ln, float (&rs)[2][4]) {
    f32x4 a[2][4], b[2][4];
#pragma unroll
    for (int ai = 0; ai < 2; ++ai)
#pragma unroll
        for (int m = 0; m < 4; ++m) { const float* p = SS + (size_t)(row0 + ai * HALF + m * 16) * 32 + 8 * fq; a[ai][m] = *(const f32x4*)p; b[ai][m] = *(const f32x4*)(p + 4); }
#pragma unroll
    for (int ai = 0; ai < 2; ++ai)
#pragma unroll
        for (int m = 0; m < 4; ++m) {
            float s = ((a[ai][m][0] + a[ai][m][1]) + (a[ai][m][2] + a[ai][m][3])) + ((b[ai][m][0] + b[ai][m][1]) + (b[ai][m][2] + b[ai][m][3]));
            s += shx(s, 16, ln); s += shx(s, 32, ln);
            rs[ai][m] = rsqrtf(s * (1.0f / D) + RMS_EPS);
        }
}
DI void row_rs4(const float* SS, int rowb, int fq, int ln, float (&rs)[4]) {
    f32x4 a[4], b[4];
#pragma unroll
    for (int m = 0; m < 4; ++m) { const float* p = SS + (size_t)(rowb + m * 16) * 32 + 8 * fq; a[m] = *(const f32x4*)p; b[m] = *(const f32x4*)(p + 4); }
#pragma unroll
    for (int m = 0; m < 4; ++m) {
        float s = ((a[m][0] + a[m][1]) + (a[m][2] + a[m][3])) + ((b[m][0] + b[m][1]) + (b[m][2] + b[m][3]));
        s += shx(s, 16, ln); s += shx(s, 32, ln);
        rs[m] = rsqrtf(s * (1.0f / D) + RMS_EPS);
    }
}
DI float row_rs(const float* SS, int row, int fq, int ln) {
    const f32x4 a = *(const f32x4*)(SS + (size_t)row * 32 + 8 * fq), b = *(const f32x4*)(SS + (size_t)row * 32 + 8 * fq + 4);
    float s = ((a[0] + a[1]) + (a[2] + a[3])) + ((b[0] + b[1]) + (b[2] + b[3]));
    s += shx(s, 16, ln); s += shx(s, 32, ln);
    return rsqrtf(s * (1.0f / D) + RMS_EPS);
}
DI void rs_prepass(const float* SS, int rowbase, LAS float* RSL, int tid) {
#pragma unroll
    for (int i = 0; i < 4; ++i) {
        const int r = tid + 512 * i; const f32x4* p = (const f32x4*)(SS + (size_t)(rowbase + r) * 32);
        f32x4 v[8];
#pragma unroll
        for (int j = 0; j < 8; ++j) v[j] = p[j];
        float s = 0.f;
#pragma unroll
        for (int j = 0; j < 8; ++j) s += (v[j][0] + v[j][1]) + (v[j][2] + v[j][3]);
        RSL[r] = rsqrtf(s * (1.0f / D) + RMS_EPS);
    }
    __syncthreads();
}
template <bool W8, bool O8 = false> struct EpiSwiglu {
    static constexpr bool PROBE2 = false;
    static constexpr bool PERM = true, AFTER_DRAIN = false;
    bf16_t* O; const float* SS; LAS const float* RSL; int rowbase;
    DI void operator()(const f32x4 (&acc)[2][2][4][2], const Unit& u, int wr, int wc, int fr, int fq) const {
        asm volatile("" : "+v"(fr), "+v"(fq));
        const int row0 = u.pm * BM + wr * 64 + fr, col0 = u.pn * HALF + wc * 32 + 8 * fq;
        const bool inl = RSL != nullptr && (unsigned)(u.pm * BM - rowbase) < 2048u;
#pragma unroll
        for (int ai = 0; ai < 2; ++ai) {
            float rs4[4];
            if (inl) {
#pragma unroll
                for (int m = 0; m < 4; ++m) rs4[m] = RSL[row0 + ai * HALF + m * 16 - rowbase];
            } else row_rs4(SS, row0 + ai * HALF, fq, fr + 16 * fq, rs4);
#pragma unroll
            for (int m = 0; m < 4; ++m) {
                const size_t ro = (size_t)(row0 + ai * HALF + m * 16) * FF + col0;
                const float rs = W8 ? rs4[m] * (1.0f / W8_SCALE) : rs4[m];
                const float k1 = -1.4426950408889634f * rs, k2 = O8 ? rs * rs * ACT8_SCALE : rs * rs;
                f32x4 a, b;
#pragma unroll
                for (int e = 0; e < 4; ++e) {
                    const float g0 = acc[ai][0][m][0][e], u0 = acc[ai][1][m][0][e], g1 = acc[ai][0][m][1][e], u1 = acc[ai][1][m][1][e];
                    a[e] = (g0 * u0) * __builtin_amdgcn_rcpf(1.0f + __builtin_amdgcn_exp2f(k1 * g0)) * k2;
                    b[e] = (g1 * u1) * __builtin_amdgcn_rcpf(1.0f + __builtin_amdgcn_exp2f(k1 * g1)) * k2;
                }
                if (O8) *(u32x2*)((unsigned char*)O + ro) = pack8_fp8(a, b);
                else *(u32x4*)(O + ro) = pack8(a, b);
            }
        }
    }
};

template <int HALFSTEP, bool W8 = false> struct EpiResid {
    static constexpr bool PROBE2 = false;
    static constexpr bool PERM = true, AFTER_DRAIN = false;
    static constexpr float scale = (HALFSTEP ? 0.5f : 1.0f) * (W8 ? 1.0f / (W8_SCALE * ACT8_SCALE) : 1.0f);
    bf16_t* XB; unsigned char* XB8; float* SSout;
    DI void operator()(const f32x4 (&acc)[2][2][4][2], const Unit& u, int wr, int wc, int fr, int fq) const {
        asm volatile("" : "+v"(fr), "+v"(fq));
        const int row0 = u.pm * BM + wr * 64 + fr, col0 = u.pn * BM + wc * 32 + 8 * fq, ln = fr + 16 * fq;
#pragma unroll
        for (int ai = 0; ai < 2; ++ai) {
            u32x4 xv[4][2];
#pragma unroll
            for (int m = 0; m < 4; ++m)
#pragma unroll
                for (int bj = 0; bj < 2; ++bj) xv[m][bj] = *(const u32x4*)(XB + (size_t)(row0 + ai * HALF + m * 16) * D + col0 + bj * HALF);
#pragma unroll
            for (int m = 0; m < 4; ++m) {
                const int row = row0 + ai * HALF + m * 16;
                const size_t ro = (size_t)row * D + col0;
                float ss = 0.f;
#pragma unroll
                for (int bj = 0; bj < 2; ++bj) {
                    const u32x4 x = xv[m][bj];
                    const f32x4 x0 = {bf_lo(x.x), bf_hi(x.x), bf_lo(x.y), bf_hi(x.y)}, x1 = {bf_lo(x.z), bf_hi(x.z), bf_lo(x.w), bf_hi(x.w)};
                    const f32x4 y0 = x0 + scale * acc[ai][bj][m][0], y1 = x1 + scale * acc[ai][bj][m][1];
                    *(u32x4*)(XB + ro + bj * HALF) = pack8(y0, y1);
                    if (XB8) *(u32x2*)(XB8 + ro + bj * HALF) = pack8_fp8(y0, y1);
                    ss += ((y0[0] * y0[0] + y0[1] * y0[1]) + (y0[2] * y0[2] + y0[3] * y0[3])) + ((y1[0] * y1[0] + y1[1] * y1[1]) + (y1[2] * y1[2] + y1[3] * y1[3]));
                }
                ss += shx(ss, 16, ln); ss += shx(ss, 32, ln);
                if (fq == 0) SSout[(size_t)row * 32 + u.pn * 4 + wc] = ss;
            }
        }
    }
};

template <int MODE> struct EpiProj {
    static constexpr bool PERM = true, AFTER_DRAIN = false, PROBE2 = MODE == 0;
    bf16_t *Q, *K, *V, *QI, *KI, *QM; float* WI; const float* COS; const float* SIN; const float* kgain; const float* SS; LAS const float* RSL; int rowbase;
    template <bool FP8 = false> DI void rope128_tile(const f32x4 (&acc)[2][2][4][2], bf16_t* dst, int heads_per_row, int head0, int row0, int wc, int fq, const float (&rs8)[2][4]) const {
        const int g = 4 * wc + fq;
#pragma unroll
        for (int ai = 0; ai < 2; ++ai) {
            f32x4 cs[4], sn[4];
#pragma unroll
            for (int m = 0; m < 4; ++m) { const unsigned o = (unsigned)(row0 + ai * HALF + m * 16) * 64u + 4u * g; cs[m] = *(const f32x4*)(COS + o); sn[m] = *(const f32x4*)(SIN + o); }
#pragma unroll
            for (int m = 0; m < 4; ++m) {
                const int row = row0 + ai * HALF + m * 16;
                const f32x4 c = cs[m], s = sn[m];
                const float rs = rs8[ai][m];
#pragma unroll
                for (int bj = 0; bj < 2; ++bj) {
                    const f32x4 x1 = acc[ai][bj][m][0] * rs, x2 = acc[ai][bj][m][1] * rs;
                    const f32x4 y1 = x1 * c - x2 * s, y2 = x1 * s + x2 * c;
                    if (FP8) *(u32x2*)((unsigned char*)dst + ((size_t)row * heads_per_row + head0 + bj) * HD + 8 * g) = pack8_fp8(y1, y2);
                    else *(u32x4*)(dst + ((size_t)row * heads_per_row + head0 + bj) * HD + 8 * g) = pack8(y1, y2);
                }
            }
        }
    }
    template <bool FP8 = false> DI void plain_tile(const f32x4 (&acc)[2][2][4][2], bf16_t* dst, int heads_per_row, int head0, int row0, int wc, int fq, const float (&rs8)[2][4]) const {
        const int p0 = wc * 32 + 8 * fq;
#pragma unroll
        for (int ai = 0; ai < 2; ++ai)
#pragma unroll
            for (int m = 0; m < 4; ++m) {
                const int row = row0 + ai * HALF + m * 16;
                const float rs = rs8[ai][m];
#pragma unroll
                for (int bj = 0; bj < 2; ++bj) {
                    if (FP8) *(u32x2*)((unsigned char*)dst + ((size_t)row * heads_per_row + head0 + bj) * HD + p0) = pack8_fp8(acc[ai][bj][m][0] * rs, acc[ai][bj][m][1] * rs);
                    else *(u32x4*)(dst + ((size_t)row * heads_per_row + head0 + bj) * HD + p0) = pack8(acc[ai][bj][m][0] * rs, acc[ai][bj][m][1] * rs);
                }
            }
    }
    DI void operator()(const f32x4 (&acc)[2][2][4][2], const Unit& u, int wr, int wc, int fr, int fq) const {
        asm volatile("" : "+v"(fr), "+v"(fq));
        const int row0 = u.pm * BM + wr * 64 + fr, pn = u.pn, ln = fr + 16 * fq;
        float rs8[2][4];
        if (RSL != nullptr && (unsigned)(u.pm * BM - rowbase) < 2048u) {
#pragma unroll
            for (int ai = 0; ai < 2; ++ai)
#pragma unroll
                for (int m = 0; m < 4; ++m) rs8[ai][m] = RSL[row0 + ai * HALF + m * 16 - rowbase];
        } else row_rs8(SS, row0, fq, ln, rs8);
        if (MODE == 1) { if (pn < 6) rope128_tile(acc, Q, NH, 2 * pn, row0, wc, fq, rs8); else plain_tile(acc, QM, NMH, 2 * (pn - 6), row0, wc, fq, rs8); return; }
        if (MODE == 2) { if (pn < 2) rope128_tile(acc, K, NKV, 2 * pn, row0, wc, fq, rs8); else plain_tile(acc, V, NKV, 2 * (pn - 2), row0, wc, fq, rs8); return; }
        if (pn < 6) { rope128_tile(acc, Q, NH, 2 * pn, row0, wc, fq, rs8); return; }
        if (pn < 8) { rope128_tile<true>(acc, K, NKV, 2 * (pn - 6), row0, wc, fq, rs8); return; }
        if (pn < 10) { plain_tile<true>(acc, V, NKV, 2 * (pn - 8), row0, wc, fq, rs8); return; }
        if (pn >= 14 && pn < 16) { plain_tile(acc, QM, NMH, 2 * (pn - 14), row0, wc, fq, rs8); return; }
        if (pn < 14) {
            const int hh = wc >> 1, gp = (4 * wc + fq) & 7;
#pragma unroll
            for (int ai = 0; ai < 2; ++ai)
#pragma unroll
                for (int m = 0; m < 4; ++m) {
                    const int row = row0 + ai * HALF + m * 16;
                    const f32x4 c0 = *(const f32x4*)(COS + (size_t)row * 64 + 8 * gp), c1 = *(const f32x4*)(COS + (size_t)row * 64 + 8 * gp + 4);
                    const f32x4 s0 = *(const f32x4*)(SIN + (size_t)row * 64 + 8 * gp), s1 = *(const f32x4*)(SIN + (size_t)row * 64 + 8 * gp + 4);
                    const f32x4 c = {c0[0], c0[2], c1[0], c1[2]}, s = {s0[0], s0[2], s1[0], s1[2]};
                    const float rs = rs8[ai][m];
#pragma unroll
                    for (int bj = 0; bj < 2; ++bj) {
                        const int ih = ((pn - 10) * 2 + bj) * 2 + hh;
                        const f32x4 x1 = acc[ai][bj][m][0] * rs, x2 = acc[ai][bj][m][1] * rs;
                        const f32x4 y1 = x1 * c - x2 * s, y2 = x1 * s + x2 * c;
                        *(u32x4*)(QI + ((size_t)row * IH + ih) * ID + 8 * gp) = pack8(y1, y2);
                    }
                }
            return;
        }
        if (wc == 0) {
#pragma unroll
            for (int ai = 0; ai < 2; ++ai)
#pragma unroll
                for (int m = 0; m < 4; ++m) {
                    const int row = row0 + ai * HALF + m * 16;
                    const float rsx = rs8[ai][m];
                    float ss = 0.f;
#pragma unroll
                    for (int bj = 0; bj < 2; ++bj)
#pragma unroll
                        for (int n = 0; n < 2; ++n) { const f32x4 x = acc[ai][bj][m][n] * rsx; ss += (x[0] * x[0] + x[1] * x[1]) + (x[2] * x[2] + x[3] * x[3]); }
                    ss += shx(ss, 16, ln); ss += shx(ss, 32, ln);
                    const float rs = rsqrtf(ss * (1.0f / 64.0f) + RMS_EPS);
#pragma unroll
                    for (int n = 0; n < 2; ++n) {
                        const f32x4 ga = *(const f32x4*)(kgain + 8 * fq + 4 * n), gb = *(const f32x4*)(kgain + 32 + 8 * fq + 4 * n);
                        const f32x4 t0 = *(const f32x4*)(COS + (size_t)row * 64 + 16 * fq + 8 * n), t1 = *(const f32x4*)(COS + (size_t)row * 64 + 16 * fq + 8 * n + 4);
                        const f32x4 u0 = *(const f32x4*)(SIN + (size_t)row * 64 + 16 * fq + 8 * n), u1 = *(const f32x4*)(SIN + (size_t)row * 64 + 16 * fq + 8 * n + 4);
                        const f32x4 c = {t0[0], t0[2], t1[0], t1[2]}, s = {u0[0], u0[2], u1[0], u1[2]};
                        const f32x4 a = acc[ai][0][m][n] * (rsx * rs) * ga, b = acc[ai][1][m][n] * (rsx * rs) * gb;
                        const f32x4 y1 = a * c - b * s, y2 = a * s + b * c;
                        *(u32x4*)(KI + ((size_t)((row >> 5) * 4 + fq) * 2 + n) * 256 + (row & 31) * 8) = pack8(y1, y2);
                    }
                    __builtin_amdgcn_sched_barrier(0);
                }
        } else if (wc == 1) {
#pragma unroll
            for (int ai = 0; ai < 2; ++ai)
#pragma unroll
                for (int m = 0; m < 4; ++m) {
                    const int row = row0 + ai * HALF + m * 16;
                    const float rsx = rs8[ai][m];
                    if (fq < 2) {
#pragma unroll
                        for (int n = 0; n < 2; ++n) *(f32x4*)(WI + (size_t)row * IH + 8 * fq + 4 * n) = acc[ai][0][m][n] * (IDX_W_SCALE * rsx);
                    }
                }
        }
    }
};

enum { CT_ID = 0, CT_GU = 1, CT_WINA = 2, CT_WINB = 3, CT_WKV = 4 };
DI int conv_srccol(int type, int np) {
    const int tile = np >> 8, bj = (np >> 7) & 1, p = np & 127;
    switch (type) {
    case CT_ID: return np;
    case CT_GU: return bj * FF + tile * 128 + p;
    case CT_WINA:
        if (tile < 6) return (2 * tile + bj) * HD + rope128_src(p);
        if (tile < 8) return 1536 + (2 * (tile - 6) + bj) * HD + rope128_src(p);
        if (tile < 10) return 2048 + (2 * (tile - 8) + bj) * HD + p;
        if (tile < 14) return 2560 + ((((tile - 10) * 2 + bj) * 2) + (p >> 6)) * ID + rope64_src(p & 63);
        if (tile < 16) return 3664 + (2 * (tile - 14) + bj) * HD + p;
        if (bj == 0) return p < 32 ? 3584 + p : (p < 48 ? 3648 + (p - 32) : -1);
        return p < 32 ? 3584 + 32 + p : -1;
    case CT_WINB:
        if (tile < 6) return (2 * tile + bj) * HD + rope128_src(p);
        return 1536 + (2 * (tile - 6) + bj) * HD + p;
    default:
        if (tile < 2) return (2 * tile + bj) * HD + rope128_src(p);
        return 512 + (2 * (tile - 2) + bj) * HD + p;
    }
}
struct ConvJob { const float* src; const float* gain; unsigned char* dst; int ld, K, type, fp8, n0, k0; };
#ifndef CONV_WIDE
#define CONV_WIDE 2
#endif
#if CONV_WIDE == 1
DI void conv_job_tile(ConvJob& j, int tl, int nnt64) { const int nnt = nnt64 >> 2; j.n0 = (tl % nnt) * 256; j.k0 = (tl / nnt) * 64; }
#else
DI void conv_job_tile(ConvJob& j, int tl, int nnt) { j.n0 = (tl % nnt) * 64; j.k0 = (tl / nnt) * 256; }
#endif
DI void conv_load(const ConvJob& j, f32x4 (&v)[8], f32x4 (&g)[2], int kg, int nq, float zf) {
    const int sc = conv_srccol(j.type, j.n0 + 4 * nq), k0 = j.k0 + 8 * kg;
#pragma unroll
    for (int r = 0; r < 8; ++r) v[r] = sc >= 0 ? *(const f32x4*)(j.src + (size_t)(k0 + r) * j.ld + sc) : (f32x4){zf, zf, zf, zf};
    if (j.gain) { g[0] = *(const f32x4*)(j.gain + k0); g[1] = *(const f32x4*)(j.gain + k0 + 4); } else { g[0] = (f32x4){zf, zf, zf, zf}; g[1] = g[0]; }
}
DI void conv_store(const ConvJob& j, f32x4 (&v)[8], f32x4 (&g)[2], int kg, int nq) {
    const int k0 = j.k0 + 8 * kg, n = j.n0 + 4 * nq;
    if (j.gain) {
        const float sc = j.fp8 ? W8_SCALE : 1.0f;
#pragma unroll
        for (int r = 0; r < 8; ++r) v[r] = v[r] * (g[r >> 2][r & 3] * sc);
    } else if (j.fp8) {
#pragma unroll
        for (int r = 0; r < 8; ++r) v[r] = v[r] * W8_SCALE;
    }
#pragma unroll
    for (int e = 0; e < 4; ++e) {
        const f32x4 a = {v[0][e], v[1][e], v[2][e], v[3][e]}, b = {v[4][e], v[5][e], v[6][e], v[7][e]};
        if (j.fp8) *(u32x2*)(j.dst + (size_t)(n + e) * j.K + k0) = pack8_fp8(a, b);
        else *(u32x4*)((bf16_t*)j.dst + (size_t)(n + e) * j.K + k0) = pack8(a, b);
    }
}

DI void memkv_unit(int unit, const float* mem, const float* gain_all, const float* W_all, bf16_t* MEMK, bf16_t* MEMVT, LAS float* hn, int tid) {
    const int L = unit >> 7, m0 = ((unit >> 2) & 31) * 8, cg = unit & 3, wave = tid >> 6, lane = tid & 63;
    {
        const f32x4* xp = (const f32x4*)(mem + (size_t)(m0 + wave) * D); const f32x4* gp = (const f32x4*)(gain_all + (size_t)L * D);
        f32x4 v[8]; float ss = 0.f;
#pragma unroll
        for (int i = 0; i < 8; ++i) { v[i] = xp[lane + 64 * i]; ss += (v[i][0] * v[i][0] + v[i][1] * v[i][1]) + (v[i][2] * v[i][2] + v[i][3] * v[i][3]); }
        ss = wave_sum(ss, lane); const float rs = rsqrtf(ss * (1.0f / D) + RMS_EPS);
#pragma unroll
        for (int i = 0; i < 8; ++i) { const f32x4 y = v[i] * rs * gp[lane + 64 * i]; *(LAS f32x4*)(hn + wave * D + 4 * (lane + 64 * i)) = y; }
    }
    __syncthreads();
    const int kg = wave, cq = lane;
    const float* W = W_all + (size_t)L * D * KVW + (size_t)kg * (D / 8) * KVW + cg * 256 + 4 * cq;
    LAS const float* hk = hn + kg * (D / 8);
    f32x4 a4[8];
#pragma unroll
    for (int r = 0; r < 8; ++r) a4[r] = (f32x4){0.f, 0.f, 0.f, 0.f};
#pragma unroll 8
    for (int k = 0; k < D / 8; ++k) {
        const f32x4 w4 = *(const f32x4*)(W + (size_t)k * KVW);
#pragma unroll
        for (int r = 0; r < 8; ++r) { const float hv = hk[r * D + k]; a4[r] += hv * w4; }
    }
    LAS float* red = hn + 8 * D;
#pragma unroll
    for (int r = 0; r < 8; ++r) *(LAS f32x4*)(red + (kg * 8 + r) * 256 + 4 * cq) = a4[r];
    __syncthreads();
    {
        const int r = tid >> 6, c0 = 4 * (tid & 63);
        f32x4 v = *(LAS const f32x4*)(red + r * 256 + c0);
#pragma unroll
        for (int g8 = 1; g8 < 8; ++g8) v += *(LAS const f32x4*)(red + (g8 * 8 + r) * 256 + c0);
        const int m = m0 + r;
#pragma unroll
        for (int e = 0; e < 4; ++e) {
            const int col = cg * 256 + c0 + e, isv = col >> 9, hm = (col >> 7) & 3, d = col & 127;
            bf16_t* dst = (isv ? MEMVT : MEMK) + (size_t)(L * NMH + hm) * NMEM * HD;
            dst[isv ? vtblk_off(m, d) : kblk_off(m, d)] = (bf16_t)(pk_bf16(v[e], 0.f) & 0xffffu);
        }
    }
    __syncthreads();
}

DI void xcopy_rows(const float* X, bf16_t* XB, unsigned char* XB8, float* SSo, int gw, int W, int lane) {
    for (int row = gw; row < S; row += W) {
        const f32x4* xp = (const f32x4*)(X + (size_t)row * D);
        f32x4 v[8]; float ss = 0.f;
#pragma unroll
        for (int i = 0; i < 8; ++i) { v[i] = xp[lane + 64 * i]; ss += (v[i][0] * v[i][0] + v[i][1] * v[i][1]) + (v[i][2] * v[i][2] + v[i][3] * v[i][3]); }
        ss = wave_sum(ss, lane);
#pragma unroll
        for (int i = 0; i < 8; ++i) { u32x2 w; w.x = pk_bf16(v[i][0], v[i][1]); w.y = pk_bf16(v[i][2], v[i][3]); *(u32x2*)(XB + (size_t)row * D + 4 * (lane + 64 * i)) = w;
            if (XB8) { int b8 = 0; b8 = __builtin_amdgcn_cvt_pk_fp8_f32(v[i][0], v[i][1], b8, false); b8 = __builtin_amdgcn_cvt_pk_fp8_f32(v[i][2], v[i][3], b8, true); *(int*)(XB8 + (size_t)row * D + 4 * (lane + 64 * i)) = b8; } }
        if (lane < 32) SSo[(size_t)row * 32 + lane] = lane == 0 ? ss : 0.f;
    }
}
DI void final_norm_rows(const bf16_t* XB, float* Xout, const float* g, const float* SS, int gw, int W, int lane) {
    for (int row = gw; row < S; row += W) {
        const u32x4* xp = (const u32x4*)(XB + (size_t)row * D); f32x4* op = (f32x4*)(Xout + (size_t)row * D);
        const float rs = rsqrtf(wave_sum(lane < 32 ? SS[(size_t)row * 32 + lane] : 0.f, lane) * (1.0f / D) + RMS_EPS);
#pragma unroll
        for (int i = 0; i < 4; ++i) {
            const u32x4 x = xp[lane + 64 * i]; const f32x4 g0 = ((const f32x4*)g)[2 * (lane + 64 * i)], g1 = ((const f32x4*)g)[2 * (lane + 64 * i) + 1];
            const f32x4 x0 = {bf_lo(x.x), bf_hi(x.x), bf_lo(x.y), bf_hi(x.y)}, x1 = {bf_lo(x.z), bf_hi(x.z), bf_lo(x.w), bf_hi(x.w)};
            op[2 * (lane + 64 * i)] = x0 * rs * g0; op[2 * (lane + 64 * i) + 1] = x1 * rs * g1;
        }
    }
}

DI void kvpost_unit(int unit, const bf16_t* Kb, const bf16_t* Vb, float* KMEAN, bf16_t* KBLK, bf16_t* VTBLK, LAS unsigned char* lds, int tid) {
    const int g = unit & 3, n = unit >> 2;
    LAS unsigned short* lk = (LAS unsigned short*)lds;
    LAS unsigned short* lv = (LAS unsigned short*)(lds + 65536);
    LAS float* part = (LAS float*)(lds + STAGE_LDS + 1024);
#pragma unroll
    for (int i = 0; i < 8; ++i) {
        const int item = tid + 512 * i, key = item >> 4, c = item & 15;
        const size_t src = ((size_t)(n * MBLK + key) * NKV + g) * HD + 8 * c;
        *(LAS u32x4*)(lk + key * HD + 8 * c) = *(const u32x4*)(Kb + src);
        *(LAS u32x4*)(lv + key * HD + 8 * c) = *(const u32x4*)(Vb + src);
    }
    __syncthreads();
    {
        const int d = tid & 127, part_id = tid >> 7; float s = 0.f;
        for (int k = 0; k < 64; ++k) s += bf_lo((unsigned)lk[(part_id * 64 + k) * HD + d]);
        part[part_id * 128 + d] = s;
    }
    const size_t bb = (size_t)(g * NBLK + n) * MBLK * HD;
#pragma unroll
    for (int i = 0; i < 8; ++i) {
        const int item = tid + 512 * i, ln = item & 63, ks = (item >> 6) & 7, mt = item >> 9, r = ln & 31, h = ln >> 5;
        *(u32x4*)(KBLK + bb + (size_t)item * 8) = *(const LAS u32x4*)(lk + (32 * mt + r) * HD + 16 * ks + 8 * h);
    }
#pragma unroll
    for (int i = 0; i < 8; ++i) {
        const int item = tid + 512 * i, ln = item & 63, s2 = (item >> 6) & 1, mt = (item >> 7) & 7, dt = item >> 10, r = ln & 31, h = ln >> 5;
        unsigned short e[8];
#pragma unroll
        for (int j = 0; j < 8; ++j) e[j] = lv[vt_pos(32 * mt + 16 * s2 + 8 * h + j) * HD + 32 * dt + r];
        u32x4 w; w.x = e[0] | ((unsigned)e[1] << 16); w.y = e[2] | ((unsigned)e[3] << 16); w.z = e[4] | ((unsigned)e[5] << 16); w.w = e[6] | ((unsigned)e[7] << 16);
        *(u32x4*)(VTBLK + bb + (size_t)item * 8) = w;
    }
    __syncthreads();
    if (tid < 128) KMEAN[(size_t)(g * NBLK + n) * HD + tid] = (part[tid] + part[128 + tid] + part[256 + tid] + part[384 + tid]) * (1.0f / MBLK);
    __syncthreads();
}
#define MFMA32(a, b, c) __builtin_amdgcn_mfma_f32_32x32x16_bf16((a), (b), (c), 0, 0, 0)
#define MFMA16(a, b, c) __builtin_amdgcn_mfma_f32_16x16x32_bf16((a), (b), (c), 0, 0, 0)
typedef unsigned v4u32 __attribute__((ext_vector_type(4)));
DI const bf16_t* uni_ptr(const bf16_t* p) { const unsigned long long v = (unsigned long long)p; const unsigned lo = __builtin_amdgcn_readfirstlane((unsigned)v), hi = __builtin_amdgcn_readfirstlane((unsigned)(v >> 32)); return (const bf16_t*)(((unsigned long long)hi << 32) | lo); }
DI bf16x8 bload(__amdgpu_buffer_rsrc_t rs, unsigned voff, unsigned soff) { return __builtin_bit_cast(bf16x8, __builtin_amdgcn_raw_buffer_load_b128(rs, voff, soff, 0)); }
constexpr int LCAP = 640;
DI float vmax3(float a, float b, float c) { float r; asm volatile("v_max3_f32 %0, %1, %2, %3" : "=v"(r) : "v"(a), "v"(b), "v"(c)); return r; }
DI unsigned fkey(float f) { const unsigned u = __float_as_uint(f); return u ^ ((unsigned)((int)u >> 31) | 0x80000000u); }
DI float funkey(unsigned k) { return __uint_as_float((k & 0x80000000u) ? (k ^ 0x80000000u) : ~k); }
DI int lane_prefix(unsigned long long m) { return (int)__builtin_amdgcn_mbcnt_hi((unsigned)(m >> 32), __builtin_amdgcn_mbcnt_lo((unsigned)m, 0u)); }

constexpr int SEL_NE = LCAP / 64, SEL_SLACK = 64;
template <bool EXACT> DI int select256(LAS float* lv, LAS unsigned short* li, int cnt, int lane, float& tau) {
    lds_fence();
    unsigned ku[SEL_NE]; unsigned id[SEL_NE];
    unsigned kmin = 0xffffffffu, kmax = 0u;
#pragma unroll
    for (int e = 0; e < SEL_NE; ++e) {
        const int idx = e * 64 + lane; const bool in = idx < cnt;
        const float v = lv[in ? idx : 0]; id[e] = li[in ? idx : 0];
        ku[e] = in ? fkey(v) : 0u;
        kmin = in ? (ku[e] < kmin ? ku[e] : kmin) : kmin; kmax = ku[e] > kmax ? ku[e] : kmax;
    }
#pragma unroll
    for (int o = 32; o >= 1; o >>= 1) { const unsigned a = shxu(kmin, o, lane), b = shxu(kmax, o, lane); kmin = a < kmin ? a : kmin; kmax = b > kmax ? b : kmax; }
    unsigned lo = __builtin_amdgcn_readfirstlane(kmin), hi = __builtin_amdgcn_readfirstlane(kmax) + 1u;
    while (hi - lo > 1u) {
        const unsigned mid = lo + ((hi - lo) >> 1);
        int c = 0;
#pragma unroll
        for (int e = 0; e < SEL_NE; ++e) c += __popcll(__ballot(ku[e] >= mid));
        if (c >= TOPK) lo = mid; else hi = mid;
        if (EXACT ? (c == TOPK) : (c >= TOPK && c <= TOPK + SEL_SLACK)) break;
    }
    const unsigned tk = lo;
    int need = LCAP;
    if (EXACT) {
        int ngt = 0;
#pragma unroll
        for (int e = 0; e < SEL_NE; ++e) ngt += __popcll(__ballot(ku[e] > tk));
        need = TOPK - ngt;
    }
    int base = 0, eqbase = 0;
    lds_fence();
#pragma unroll
    for (int e = 0; e < SEL_NE; ++e) {
        const bool eq = ku[e] == tk; const unsigned long long meq = __ballot(eq);
        const int eqrank = eqbase + lane_prefix(meq);
        const bool keep = (ku[e] > tk) || (eq && eqrank < need);
        const unsigned long long mk = __ballot(keep);
        const int pos = base + lane_prefix(mk);
        if (keep) { lv[pos] = funkey(ku[e]); li[pos] = (unsigned short)id[e]; }
        base += __popcll(mk); eqbase += __popcll(meq);
    }
    lds_fence();
    tau = funkey(tk);
    return base;
}

DI f32x16 idx_fake_mm(bf16x8 a, bf16x8 b, f32x16 c) { asm volatile("" : "+v"(c) : "v"(a), "v"(b)); return c; }
template <int PROBE_MODE = 0> DI void idx_phase(const bf16_t* QI, const bf16_t* KI, const float* WI, unsigned short* SEL, int* NSEL, LAS unsigned char* lds, int tid, int bid, int G,
                                                int gw_ov = -1, int W_ov = 0, LAS unsigned char* lwave = nullptr, volatile LAS int* flag = nullptr) {
    const int lane = tid & 63, wave = __builtin_amdgcn_readfirstlane(tid >> 6), gw = gw_ov >= 0 ? gw_ov : bid * NWAVES + wave, W = gw_ov >= 0 ? W_ov : G * NWAVES;
    LAS unsigned char* lw = gw_ov >= 0 ? lwave : lds + wave * (LCAP * 24);
    LAS float* LV = (LAS float*)lw; LAS unsigned short* LI = (LAS unsigned short*)(lw + LCAP * 16);
    int done = 0;
    const int h = lane >> 5, r = lane & 31;
    constexpr int NU = S / 4;
    const __amdgpu_buffer_rsrc_t rsKI = __builtin_amdgcn_make_buffer_rsrc((void*)uni_ptr(KI), (short)0, S * ID * 2, 0x00020000);
    for (int i0 = gw; i0 < NU / 2; i0 += W)
        for (int rep = 0; rep < 2; ++rep) {
            const int u = rep ? (NU - 1 - i0) : i0, t0 = 4 * u;
            bf16x8 af[2][4]; float wv[2][16];
#pragma unroll
            for (int p = 0; p < 2; ++p) {
                const int qsel = (r >> 2) & 1, hd = (r & 3) + 4 * (r >> 3);
                const bf16_t* qp = QI + ((size_t)(t0 + 2 * p + qsel) * IH + hd) * ID + 8 * h;
#pragma unroll
                for (int ks = 0; ks < 4; ++ks) af[p][ks] = *(const bf16x8*)(qp + 16 * ks);
                const f32x4* wp = (const f32x4*)(WI + (size_t)(t0 + 2 * p + h) * IH);
#pragma unroll
                for (int j = 0; j < 4; ++j) { const f32x4 w4 = wp[j]; wv[p][4 * j] = w4[0]; wv[p][4 * j + 1] = w4[1]; wv[p][4 * j + 2] = w4[2]; wv[p][4 * j + 3] = w4[3]; }
            }
            int cnt[4] = {0, 0, 0, 0}; float tau[4];
#pragma unroll
            for (int q = 0; q < 4; ++q) tau[q] = -__builtin_inff();
            float taul[2] = {-__builtin_inff(), -__builtin_inff()};
            const int ntile = (t0 + 3) / 32 + 1;
            bf16x8 ring[4][4];
#define IDX_LOAD(slot, tile) do { if (PROBE_MODE == 3 && (tile) > 2) break; const unsigned so_ = (unsigned)((tile) < ntile ? (tile) : ntile - 1) * 4096u; \
        _Pragma("unroll") for (int ks = 0; ks < 4; ++ks) ring[slot][ks] = bload(rsKI, (unsigned)lane * 16u, so_ + 1024u * ks); } while (0)
            IDX_LOAD(0, 0); IDX_LOAD(1, 1); IDX_LOAD(2, 2);
#define IDX_CHUNK0(acc, p, sc) do { if (PROBE_MODE == 4) { asm volatile("" :: "v"(acc[0]), "v"(acc[15])); break; } float y0_, y1_, y2_, y3_; \
        asm volatile("s_nop 1\n\tv_max_i32 %0, 0, %4\n\tv_max_i32 %1, 0, %5\n\tv_max_i32 %2, 0, %6\n\tv_max_i32 %3, 0, %7" : "=&v"(y0_), "=&v"(y1_), "=&v"(y2_), "=&v"(y3_) : "v"(acc[0]), "v"(acc[1]), "v"(acc[2]), "v"(acc[3])); \
        sc = fmaf(wv[p][0], y0_, sc); sc = fmaf(wv[p][1], y1_, sc); sc = fmaf(wv[p][2], y2_, sc); sc = fmaf(wv[p][3], y3_, sc); } while (0)
#define IDX_CHUNKN(acc, p, c, sc) do { if (PROBE_MODE == 4) break; float y0_, y1_, y2_, y3_; \
        asm volatile("v_max_i32 %0, 0, %4\n\tv_max_i32 %1, 0, %5\n\tv_max_i32 %2, 0, %6\n\tv_max_i32 %3, 0, %7" : "=&v"(y0_), "=&v"(y1_), "=&v"(y2_), "=&v"(y3_) : "v"(acc[4 * (c)]), "v"(acc[4 * (c) + 1]), "v"(acc[4 * (c) + 2]), "v"(acc[4 * (c) + 3])); \
        sc = fmaf(wv[p][4 * (c)], y0_, sc); sc = fmaf(wv[p][4 * (c) + 1], y1_, sc); sc = fmaf(wv[p][4 * (c) + 2], y2_, sc); sc = fmaf(wv[p][4 * (c) + 3], y3_, sc); } while (0)
  \
#define IDX_FILTER(p, ktv, scv) do { if (PROBE_MODE >= 2) { tau[2 * (p)] += (scv) + 0.0f; break; } \
        if (__builtin_amdgcn_ballot_w64((scv) > taul[p]) != 0ull) { \
            const float sc_ = (scv) + 0.0f; const int key_ = 32 * (ktv) + r, tq_ = t0 + 2 * (p) + h; \
            const bool pass_ = (key_ <= tq_) && (sc_ > taul[p]); const unsigned long long mask_ = __builtin_amdgcn_ballot_w64(pass_); \
            if (mask_ != 0ull) { const unsigned mlo_ = (unsigned)mask_, mhi_ = (unsigned)(mask_ >> 32); const unsigned mym_ = h ? mhi_ : mlo_; \
                const int slot_ = (h ? cnt[2 * (p) + 1] : cnt[2 * (p)]) + __popc(mym_ & ((1u << r) - 1u)); \
                if (pass_) { LV[(2 * (p) + h) * LCAP + slot_] = sc_; LI[(2 * (p) + h) * LCAP + slot_] = (unsigned short)key_; } \
                cnt[2 * (p)] = __builtin_amdgcn_readfirstlane(cnt[2 * (p)] + __popc(mlo_)); cnt[2 * (p) + 1] = __builtin_amdgcn_readfirstlane(cnt[2 * (p) + 1] + __popc(mhi_)); } } } while (0)
#define IDX_SB __builtin_amdgcn_sched_barrier(0)
#define IDX_MM(a_, b_, c_) (PROBE_MODE == 5 ? idx_fake_mm((a_), (b_), (c_)) : MFMA32((a_), (b_), (c_)))
            f32x16 zero16;
#pragma unroll
            for (int j = 0; j < 16; ++j) zero16[j] = 0.f;
            f32x16 accA = zero16, accB = zero16;
            for (int kt0 = 0; kt0 < ntile; kt0 += 4)
#pragma unroll
            for (int u4 = 0; u4 < 4; ++u4) {
                const int kt = kt0 + u4;
                if (kt >= ntile) break;
                IDX_LOAD((u4 + 3) & 3, kt + 3);
                bf16x8 bfr[4];
#pragma unroll
                for (int ks = 0; ks < 4; ++ks) bfr[ks] = ring[u4][ks];
                if (kt > 0) {
                    float scB = 0.f;
                    IDX_SB; accA = IDX_MM(af[0][0], bfr[0], zero16); IDX_SB; IDX_CHUNK0(accB, 1, scB);
                    IDX_SB; accA = IDX_MM(af[0][1], bfr[1], accA); IDX_SB; IDX_CHUNKN(accB, 1, 1, scB);
                    IDX_SB; accA = IDX_MM(af[0][2], bfr[2], accA); IDX_SB; IDX_CHUNKN(accB, 1, 2, scB);
                    IDX_SB; accA = IDX_MM(af[0][3], bfr[3], accA); IDX_SB; IDX_CHUNKN(accB, 1, 3, scB);
                    IDX_FILTER(1, kt - 1, scB);
                } else {
                    accA = IDX_MM(af[0][0], bfr[0], zero16); accA = IDX_MM(af[0][1], bfr[1], accA); accA = IDX_MM(af[0][2], bfr[2], accA); accA = IDX_MM(af[0][3], bfr[3], accA);
                }
                {
                    float scA = 0.f;
                    IDX_SB; accB = IDX_MM(af[1][0], bfr[0], zero16); IDX_SB; IDX_CHUNK0(accA, 0, scA);
                    IDX_SB; accB = IDX_MM(af[1][1], bfr[1], accB); IDX_SB; IDX_CHUNKN(accA, 0, 1, scA);
                    IDX_SB; accB = IDX_MM(af[1][2], bfr[2], accB); IDX_SB; IDX_CHUNKN(accA, 0, 2, scA);
                    IDX_SB; accB = IDX_MM(af[1][3], bfr[3], accB); IDX_SB; IDX_CHUNKN(accA, 0, 3, scA);
                    IDX_FILTER(0, kt, scA);
                }
#pragma unroll
                for (int q = 0; q < 4; ++q)
                    if (PROBE_MODE < 2 && cnt[q] > LCAP - 64) {
                        cnt[q] = __builtin_amdgcn_readfirstlane(select256<false>(LV + q * LCAP, LI + q * LCAP, cnt[q], lane, tau[q]));
                        if (cnt[q] > LCAP - 64) cnt[q] = __builtin_amdgcn_readfirstlane(select256<true>(LV + q * LCAP, LI + q * LCAP, cnt[q], lane, tau[q]));
                        if (h == (q & 1)) taul[q >> 1] = tau[q];
                    }
            }
            {
                float scB = 0.f;
                IDX_CHUNK0(accB, 1, scB); IDX_CHUNKN(accB, 1, 1, scB); IDX_CHUNKN(accB, 1, 2, scB); IDX_CHUNKN(accB, 1, 3, scB);
                IDX_FILTER(1, ntile - 1, scB);
            }
#undef IDX_MM
#undef IDX_CHUNK0
#undef IDX_CHUNKN
#undef IDX_FILTER
#undef IDX_SB
#pragma unroll
            for (int q = 0; q < 4; ++q) {
                if (PROBE_MODE >= 2) { if (tau[q] == 12345.f) cnt[q] = 1; } else
                if (cnt[q] > TOPK) { float dummy; cnt[q] = select256<true>(LV + q * LCAP, LI + q * LCAP, cnt[q], lane, dummy); }
                lds_fence();
                const int t = t0 + q;
#pragma unroll
                for (int j = 0; j < 4; ++j) { const int idx = j * 64 + lane; SEL[(size_t)t * TOPK + idx] = idx < cnt[q] ? LI[q * LCAP + idx] : (unsigned short)0; }
                if (lane == 0) NSEL[t] = cnt[q];
            }
            lds_fence();
            if (flag) { __builtin_amdgcn_fence(__ATOMIC_RELEASE, "workgroup"); ++done; if (lane == 0) *flag = done; }
        }
}

DI void attn_item(const bf16_t* qrow, const bf16_t* Kblk_, const bf16_t* Vt_, bool causal, int kbase, int tq, int lane, f32x16 (&oacc)[4], float& mlog, float& lsum) {
    const int h = lane >> 5;
    const __amdgpu_buffer_rsrc_t rsK = __builtin_amdgcn_make_buffer_rsrc((void*)uni_ptr(Kblk_), (short)0, HD * MBLK * 2, 0x00020000);
    const __amdgpu_buffer_rsrc_t rsV = __builtin_amdgcn_make_buffer_rsrc((void*)uni_ptr(Vt_), (short)0, HD * MBLK * 2, 0x00020000);
    const unsigned voff = (unsigned)lane * 16u;
    constexpr int RD = 12;
    bf16x8 ring[RD];
#pragma unroll
    for (int f = 0; f < RD - 1; ++f) ring[f] = bload(rsK, voff, (unsigned)(f * 1024));
    bf16x8 qf[8];
#pragma unroll
    for (int ks = 0; ks < 8; ++ks) qf[ks] = *(const bf16x8*)(qrow + 16 * ks + 8 * h);
    f32x16 sacc[8];
#pragma unroll
    for (int mt = 0; mt < 8; ++mt) {
#pragma unroll
        for (int j = 0; j < 16; ++j) sacc[mt][j] = 0.f;
#pragma unroll
        for (int ks = 0; ks < 8; ++ks) {
            const int f = mt * 8 + ks;
            if (f + RD - 1 < 64) ring[(f + RD - 1) % RD] = bload(rsK, voff, (unsigned)((f + RD - 1) * 1024));
            sacc[mt] = MFMA32(ring[f % RD], qf[ks], sacc[mt]);
            if ((ks & 3) == 3) __builtin_amdgcn_sched_barrier(0);
        }
    }
#define VT_FRAG(u) ((unsigned)((((((u) & 3) * 8 + ((u) >> 3)) * 2) + (((u) >> 2) & 1)) * 1024))
#pragma unroll
    for (int u = 0; u < RD - 1; ++u) ring[u] = bload(rsV, voff, VT_FRAG(u));
    __builtin_amdgcn_sched_barrier(0);
    float mx = -__builtin_inff();
#pragma unroll
    for (int mt = 0; mt < 8; ++mt)
#pragma unroll
        for (int j = 0; j < 16; ++j) {
            const int key = 32 * mt + (j & 3) + 8 * (j >> 2) + 4 * h;
            float s = sacc[mt][j];
            if (causal && (kbase + key > tq)) s = -__builtin_inff();
            sacc[mt][j] = s; mx = fmaxf(mx, s);
        }
    mx = fmaxf(mx, shx(mx, 32, lane));
    mlog = mx * ATT_SC;
    float l = 0.f;
    u32x4 pw[8][2];
#pragma unroll
    for (int mt = 0; mt < 8; ++mt)
#pragma unroll
        for (int s2 = 0; s2 < 2; ++s2) {
            float p[8];
#pragma unroll
            for (int j = 0; j < 8; ++j) { p[j] = __builtin_amdgcn_exp2f(sacc[mt][8 * s2 + j] * ATT_SC - mlog); l += p[j]; }
            pw[mt][s2].x = pk_bf16(p[0], p[1]); pw[mt][s2].y = pk_bf16(p[2], p[3]); pw[mt][s2].z = pk_bf16(p[4], p[5]); pw[mt][s2].w = pk_bf16(p[6], p[7]);
        }
    l += shx(l, 32, lane);
    lsum = l;
#pragma unroll
    for (int dt = 0; dt < 4; ++dt)
#pragma unroll
        for (int j = 0; j < 16; ++j) oacc[dt][j] = 0.f;
    __builtin_amdgcn_sched_barrier(0);
#pragma unroll
    for (int mt = 0; mt < 8; ++mt)
#pragma unroll
        for (int s2 = 0; s2 < 2; ++s2) {
            const bf16x8 pb = __builtin_bit_cast(bf16x8, pw[mt][s2]);
#pragma unroll
            for (int dt = 0; dt < 4; ++dt) {
                const int u = (mt * 2 + s2) * 4 + dt;
                if (u + RD - 1 < 64) ring[(u + RD - 1) % RD] = bload(rsV, voff, VT_FRAG(u + RD - 1));
                oacc[dt] = MFMA32(ring[u % RD], pb, oacc[dt]);
            }
            __builtin_amdgcn_sched_barrier(0);
        }
#undef VT_FRAG
}

DI void memattn_item(int item, int L, const bf16_t* QM, const bf16_t* MEMK, const bf16_t* MEMVT, bf16_t* AO, int lane) {
    const int hm = item & 3, t = (item >> 2) * 32 + (lane & 31), h = lane >> 5;
    f32x16 oacc[4]; float mlog, l;
    attn_item(QM + ((size_t)t * NMH + hm) * HD, MEMK + (size_t)(L * NMH + hm) * NMEM * HD, MEMVT + (size_t)(L * NMH + hm) * HD * NMEM, false, 0, 0, lane, oacc, mlog, l);
    const float inv = 1.0f / l;
    bf16_t* op = AO + (size_t)t * D + NH * HD + hm * HD;
#pragma unroll
    for (int dt = 0; dt < 4; ++dt)
#pragma unroll
        for (int q4 = 0; q4 < 4; ++q4) {
            u32x2 w; w.x = pk_bf16(oacc[dt][4 * q4] * inv, oacc[dt][4 * q4 + 1] * inv); w.y = pk_bf16(oacc[dt][4 * q4 + 2] * inv, oacc[dt][4 * q4 + 3] * inv);
            *(u32x2*)(op + 32 * dt + 8 * q4 + 4 * h) = w;
        }
}

#define MFMA16F8(a, b, c) __builtin_amdgcn_mfma_f32_16x16x32_fp8_fp8((a), (b), (c), 0, 0, 0)
DI long mk_i64(unsigned lo, unsigned hi) { return (long)(((unsigned long long)hi << 32) | lo); }
DI void dsa_query(int t, int g0, int g1, const bf16_t* Q, const unsigned char* K8, const unsigned char* V8, const unsigned short* SEL, const int* NSEL, bf16_t* AO, LAS unsigned char* wl, int lane) {
    LAS float* Pl = (LAS float*)wl;
    LAS unsigned short* selL = (LAS unsigned short*)(wl + 4096);
    LAS float* linv = (LAS float*)(wl + 4096 + 512);
    const int ns = NSEL[t];
    {
        const u32x2 sv = *(const u32x2*)(SEL + (size_t)t * TOPK + 4 * lane);
        *(LAS u32x2*)(selL + 4 * lane) = sv;
    }
    lds_fence();
    const int c = lane & 15, kq = lane >> 4;
    const __amdgpu_buffer_rsrc_t rsK = __builtin_amdgcn_make_buffer_rsrc((void*)uni_ptr((const bf16_t*)K8), (short)0, S * NKV * HD, 0x00020000);
    const __amdgpu_buffer_rsrc_t rsV = __builtin_amdgcn_make_buffer_rsrc((void*)uni_ptr((const bf16_t*)V8), (short)0, S * NKV * HD, 0x00020000);
    long qf[4];
#pragma unroll
    for (int u = 0; u < 2; ++u) {
        unsigned zu = 0u; asm volatile("" : "+v"(zu));
        u32x4 q0 = {zu, zu, zu, zu}, q1 = {zu, zu, zu, zu};
        if (c < NH) { const u32x4* qp = (const u32x4*)(Q + ((size_t)t * NH + c) * HD + 64 * u + 16 * kq); q0 = qp[0]; q1 = qp[1]; }
        const u32x2 f0 = pack8_fp8((f32x4){bf_lo(q0.x), bf_hi(q0.x), bf_lo(q0.y), bf_hi(q0.y)}, (f32x4){bf_lo(q0.z), bf_hi(q0.z), bf_lo(q0.w), bf_hi(q0.w)});
        const u32x2 f1 = pack8_fp8((f32x4){bf_lo(q1.x), bf_hi(q1.x), bf_lo(q1.y), bf_hi(q1.y)}, (f32x4){bf_lo(q1.z), bf_hi(q1.z), bf_lo(q1.w), bf_hi(q1.w)});
        qf[2 * u] = mk_i64(f0.x, f0.y); qf[2 * u + 1] = mk_i64(f1.x, f1.y);
    }
    for (int g = g0; g < g1; ++g) {
        const unsigned gofs = (unsigned)g * HD;
        constexpr int KR = 8;
        u32x4 kr[KR][2];
#define DSA_KLOAD(slot, j) do { const unsigned vo_ = (unsigned)selL[16 * (j) + c] * (NKV * HD) + gofs + 16u * kq; \
        kr[slot][0] = __builtin_bit_cast(u32x4, bload(rsK, vo_, 0u)); kr[slot][1] = __builtin_bit_cast(u32x4, bload(rsK, vo_, 64u)); } while (0)
#pragma unroll
        for (int j = 0; j < KR - 1; ++j) DSA_KLOAD(j, j);
        f32x4 sacc[16];
#pragma unroll
        for (int j = 0; j < 16; ++j) {
            if (j + KR - 1 < 16) DSA_KLOAD((j + KR - 1) % KR, j + KR - 1);
            f32x4 a4 = {0.f, 0.f, 0.f, 0.f};
#pragma unroll
            for (int u = 0; u < 2; ++u) {
                const u32x4 kv = kr[j % KR][u];
                a4 = MFMA16F8(mk_i64(kv.x, kv.y), qf[2 * u], a4);
                a4 = MFMA16F8(mk_i64(kv.z, kv.w), qf[2 * u + 1], a4);
            }
            sacc[j] = a4;
        }
#undef DSA_KLOAD
        constexpr int VR = 24;
        u32x2 vr[VR];
#define DSA_VLOAD(slot, i) do { const unsigned vo_ = (unsigned)selL[4 * (i) + kq] * (NKV * HD) + gofs + 8u * c; vr[slot] = __builtin_bit_cast(u32x2, __builtin_amdgcn_raw_buffer_load_b64(rsV, vo_, 0u, 0)); } while (0)
#pragma unroll
        for (int i = 0; i < VR - 1; ++i) DSA_VLOAD(i, i);
        float mx = -__builtin_inff();
#pragma unroll
        for (int j = 0; j < 16; ++j)
#pragma unroll
            for (int e = 0; e < 4; ++e) { const int slot = 16 * j + 4 * kq + e; const float s = slot < ns ? sacc[j][e] : -__builtin_inff(); sacc[j][e] = s; mx = fmaxf(mx, s); }
        mx = fmaxf(mx, shx(mx, 16, lane)); mx = fmaxf(mx, shx(mx, 32, lane));
        const float ml = mx * ATT_SC; float l = 0.f;
#pragma unroll
        for (int j = 0; j < 16; ++j)
#pragma unroll
            for (int e = 0; e < 4; ++e) { const float p = __builtin_amdgcn_exp2f(sacc[j][e] * ATT_SC - ml); sacc[j][e] = p; l += p; }
        l += shx(l, 16, lane); l += shx(l, 32, lane);
        const int rr = c - 3 * g;
        if (rr >= 0 && rr < 3) {
#pragma unroll
            for (int j = 0; j < 16; ++j)
#pragma unroll
                for (int e = 0; e < 4; ++e) Pl[(16 * j + 4 * kq + e) * 4 + rr] = sacc[j][e];
            if (kq == 0) linv[rr] = 1.0f / l;
        }
        lds_fence();
        f32x2 o2[3][4];
#pragma unroll
        for (int a = 0; a < 3; ++a)
#pragma unroll
            for (int e = 0; e < 4; ++e) o2[a][e] = (f32x2){0.f, 0.f};
        for (int i0 = 0; i0 < 64; i0 += VR) {
#pragma unroll
            for (int u = 0; u < VR; ++u) {
                const int i = i0 + u;
                if (i < 64) {
                    if (i + VR - 1 < 64) DSA_VLOAD((u + VR - 1) % VR, i + VR - 1);
                    const u32x2 v = vr[u];
                    const f32x4 p = *(const LAS f32x4*)(Pl + (4 * i + kq) * 4);
                    const f32x2 v01 = __builtin_amdgcn_cvt_pk_f32_fp8((int)v.x, false), v23 = __builtin_amdgcn_cvt_pk_f32_fp8((int)v.x, true);
                    const f32x2 v45 = __builtin_amdgcn_cvt_pk_f32_fp8((int)v.y, false), v67 = __builtin_amdgcn_cvt_pk_f32_fp8((int)v.y, true);
#pragma unroll
                    for (int a = 0; a < 3; ++a) {
                        const f32x2 pp = {p[a], p[a]};
                        o2[a][0] = __builtin_elementwise_fma(pp, v01, o2[a][0]); o2[a][1] = __builtin_elementwise_fma(pp, v23, o2[a][1]);
                        o2[a][2] = __builtin_elementwise_fma(pp, v45, o2[a][2]); o2[a][3] = __builtin_elementwise_fma(pp, v67, o2[a][3]);
                    }
                }
            }
        }
#undef DSA_VLOAD
        float o[3][8];
#pragma unroll
        for (int a = 0; a < 3; ++a)
#pragma unroll
            for (int e = 0; e < 8; ++e) { float x = o2[a][e >> 1][e & 1]; x += shx(x, 16, lane); x += shx(x, 32, lane); o[a][e] = x; }
        if (kq == 0) {
#pragma unroll
            for (int a = 0; a < 3; ++a) {
                const float iv = linv[a];
                u32x4 w; w.x = pk_bf16(o[a][0] * iv, o[a][1] * iv); w.y = pk_bf16(o[a][2] * iv, o[a][3] * iv); w.z = pk_bf16(o[a][4] * iv, o[a][5] * iv); w.w = pk_bf16(o[a][6] * iv, o[a][7] * iv);
                *(u32x4*)(AO + (size_t)t * D + (3 * g + a) * HD + 8 * c) = w;
            }
        }
        lds_fence();
    }
}

#ifndef DSA_MFMA
#define DSA_MFMA 1
#endif
#define DSA_TR8(r0, r1, r2, r3, r4, r5, r6, r7, a0, a1, a2, a3, OFS) asm volatile( \
    "ds_read_b64_tr_b16 %0, %8 offset:%12\n\tds_read_b64_tr_b16 %1, %8 offset:%12+2048\n\tds_read_b64_tr_b16 %2, %9 offset:%12\n\tds_read_b64_tr_b16 %3, %9 offset:%12+2048\n\t" \
    "ds_read_b64_tr_b16 %4, %10 offset:%12\n\tds_read_b64_tr_b16 %5, %10 offset:%12+2048\n\tds_read_b64_tr_b16 %6, %11 offset:%12\n\tds_read_b64_tr_b16 %7, %11 offset:%12+2048\n\ts_waitcnt lgkmcnt(0)" \
    : "=&v"(r0), "=&v"(r1), "=&v"(r2), "=&v"(r3), "=&v"(r4), "=&v"(r5), "=&v"(r6), "=&v"(r7) : "v"(a0), "v"(a1), "v"(a2), "v"(a3), "n"(OFS) : "memory")
DI void dsa_query2(int t, int g0, int g1, const bf16_t* Q, const unsigned char* K8, const unsigned char* V8, const unsigned short* SEL, const int* NSEL, bf16_t* AO, LAS unsigned char* vb, LAS unsigned char* sl, int lane) {
    LAS unsigned short* selL = (LAS unsigned short*)sl;
    const int ns = NSEL[t];
    {
        const u32x2 sv = *(const u32x2*)(SEL + (size_t)t * TOPK + 4 * lane);
        *(LAS u32x2*)(selL + 4 * lane) = sv;
    }
    lds_fence();
    const int c = lane & 15, kq = lane >> 4;
    const __amdgpu_buffer_rsrc_t rsK = __builtin_amdgcn_make_buffer_rsrc((void*)uni_ptr((const bf16_t*)K8), (short)0, S * NKV * HD, 0x00020000);
    long qf[4];
#pragma unroll
    for (int u = 0; u < 2; ++u) {
        unsigned zu = 0u; asm volatile("" : "+v"(zu));
        u32x4 q0 = {zu, zu, zu, zu}, q1 = {zu, zu, zu, zu};
        if (c < NH) { const u32x4* qp = (const u32x4*)(Q + ((size_t)t * NH + c) * HD + 64 * u + 16 * kq); q0 = qp[0]; q1 = qp[1]; }
        const u32x2 f0 = pack8_fp8((f32x4){bf_lo(q0.x), bf_hi(q0.x), bf_lo(q0.y), bf_hi(q0.y)}, (f32x4){bf_lo(q0.z), bf_hi(q0.z), bf_lo(q0.w), bf_hi(q0.w)});
        const u32x2 f1 = pack8_fp8((f32x4){bf_lo(q1.x), bf_hi(q1.x), bf_lo(q1.y), bf_hi(q1.y)}, (f32x4){bf_lo(q1.z), bf_hi(q1.z), bf_lo(q1.w), bf_hi(q1.w)});
        qf[2 * u] = mk_i64(f0.x, f0.y); qf[2 * u + 1] = mk_i64(f1.x, f1.y);
    }
    unsigned tra[4];
    {
        const int q = (lane >> 2) & 3, p = lane & 3, sw = ((kq & 1) << 1) | (q >> 1);
#pragma unroll
        for (int db = 0; db < 4; ++db) tra[db] = (unsigned)(unsigned long long)vb + (unsigned)((4 * kq + q) * 128 + ((((db ^ sw) << 1) | (p >> 1)) << 4) + 8 * (p & 1));
    }
    const int dch = ((lane & 7) ^ (((lane >> 4) & 3) << 1)) * 16;
#pragma unroll 1
    for (int g = g0; g < g1; ++g) {
        const unsigned gofs = (unsigned)g * HD;
#define DSA_VDMA(kb) do { const unsigned key_ = (unsigned)selL[8 * (kb) + (lane >> 3)];     \
        __builtin_amdgcn_global_load_lds((const unsigned*)(V8 + (size_t)key_ * (NKV * HD) + gofs + dch), (LAS unsigned*)(vb + ((kb) & 15) * 1024), 16, 0, 0); } while (0)
        constexpr int KR = 8;
        u32x4 kr[KR][2];
#define DSA_KLOAD(slot, j) do { const unsigned vo_ = (unsigned)selL[16 * (j) + c] * (NKV * HD) + gofs + 16u * kq; \
        kr[slot][0] = __builtin_bit_cast(u32x4, bload(rsK, vo_, 0u)); kr[slot][1] = __builtin_bit_cast(u32x4, bload(rsK, vo_, 64u)); } while (0)
#pragma unroll
        for (int j = 0; j < KR - 1; ++j) DSA_KLOAD(j, j);
#pragma unroll
        for (int kb = 0; kb < 16; ++kb) DSA_VDMA(kb);
        f32x4 sacc[16];
#pragma unroll
        for (int j = 0; j < 16; ++j) {
            if (j + KR - 1 < 16) DSA_KLOAD((j + KR - 1) % KR, j + KR - 1);
            f32x4 a4 = {0.f, 0.f, 0.f, 0.f};
#pragma unroll
            for (int u = 0; u < 2; ++u) {
                const u32x4 kv = kr[j % KR][u];
                a4 = MFMA16F8(mk_i64(kv.x, kv.y), qf[2 * u], a4);
                a4 = MFMA16F8(mk_i64(kv.z, kv.w), qf[2 * u + 1], a4);
            }
            sacc[j] = a4;
        }
#undef DSA_KLOAD
        __builtin_amdgcn_sched_barrier(0);
        float mx = -__builtin_inff();
        if (ns < TOPK) {
            int nsl = ns - 4 * kq; asm volatile("" : "+v"(nsl));
#pragma unroll
            for (int j = 0; j < 16; ++j)
#pragma unroll
                for (int e = 0; e < 4; ++e) sacc[j][e] = (16 * j + e) < nsl ? sacc[j][e] : -__builtin_inff();
        }
        float mx2 = mx;
#pragma unroll
        for (int j = 0; j < 16; ++j) { mx = vmax3(mx, sacc[j][0], sacc[j][1]); mx2 = vmax3(mx2, sacc[j][2], sacc[j][3]); }
        mx = fmaxf(mx, mx2);
        mx = fmaxf(mx, shx(mx, 16, lane)); mx = fmaxf(mx, shx(mx, 32, lane));
        const float ml = mx * ATT_SC - 8.0f; float l = 0.f;
        long pa[8];
#pragma unroll
        for (int jj = 0; jj < 8; ++jj) {
            f32x4 p0, p1;
#pragma unroll
            for (int e = 0; e < 4; ++e) { p0[e] = __builtin_amdgcn_exp2f(sacc[2 * jj][e] * ATT_SC - ml); p1[e] = __builtin_amdgcn_exp2f(sacc[2 * jj + 1][e] * ATT_SC - ml); }
            l += ((p0[0] + p0[1]) + (p0[2] + p0[3])) + ((p1[0] + p1[1]) + (p1[2] + p1[3]));
            const u32x2 w = pack8_fp8(p0, p1);
            pa[jj] = mk_i64(w.x, w.y);
        }
        l += shx(l, 16, lane); l += shx(l, 32, lane);
        f32x4 oe[4], oo[4];
#pragma unroll
        for (int db = 0; db < 4; ++db) { oe[db] = (f32x4){0.f, 0.f, 0.f, 0.f}; oo[db] = (f32x4){0.f, 0.f, 0.f, 0.f}; }
#pragma unroll
        for (int ch = 0; ch < 4; ++ch) {
            if (ch < 3) asm volatile("s_waitcnt vmcnt(8)" ::: "memory"); else asm volatile("s_waitcnt vmcnt(0)" ::: "memory");
#pragma unroll
            for (int j2 = 0; j2 < 2; ++j2) {
                u32x2 r[8];
                if ((ch & 1) == 0) { if (j2 == 0) DSA_TR8(r[0], r[1], r[2], r[3], r[4], r[5], r[6], r[7], tra[0], tra[1], tra[2], tra[3], 0); else DSA_TR8(r[0], r[1], r[2], r[3], r[4], r[5], r[6], r[7], tra[0], tra[1], tra[2], tra[3], 4096); }
                else { if (j2 == 0) DSA_TR8(r[0], r[1], r[2], r[3], r[4], r[5], r[6], r[7], tra[0], tra[1], tra[2], tra[3], 8192); else DSA_TR8(r[0], r[1], r[2], r[3], r[4], r[5], r[6], r[7], tra[0], tra[1], tra[2], tra[3], 12288); }
#pragma unroll
                for (int db = 0; db < 4; ++db) {
                    const u32x2 x = r[2 * db], y = r[2 * db + 1];
                    const unsigned elo = __builtin_amdgcn_perm(x.y, x.x, 0x06040200u), ehi = __builtin_amdgcn_perm(y.y, y.x, 0x06040200u);
                    const unsigned olo = __builtin_amdgcn_perm(x.y, x.x, 0x07050301u), ohi = __builtin_amdgcn_perm(y.y, y.x, 0x07050301u);
                    oe[db] = MFMA16F8(pa[2 * ch + j2], mk_i64(elo, ehi), oe[db]);
                    oo[db] = MFMA16F8(pa[2 * ch + j2], mk_i64(olo, ohi), oo[db]);
                }
            }
            if (ch < 2) {
#pragma unroll
                for (int kb = 0; kb < 8; ++kb) DSA_VDMA(16 + 8 * ch + kb);
            }
        }
#undef DSA_VDMA
#define DSA_OUT(GG) do { _Pragma("unroll") for (int a = 0; a < 3; ++a) { constexpr int h_ = 3 * (GG) + 0; const int h = h_ + a; \
            const float iv = 1.0f / __int_as_float(__builtin_amdgcn_readlane(__float_as_int(l), h));   \
            if (kq == (h >> 2)) { _Pragma("unroll") for (int db = 0; db < 4; ++db) \
                *(unsigned*)(AO + (size_t)t * D + h * HD + 32 * db + 2 * c) = pk_bf16(oe[db][h & 3] * iv, oo[db][h & 3] * iv); } } } while (0)
        if (g == 0) DSA_OUT(0); else if (g == 1) DSA_OUT(1); else if (g == 2) DSA_OUT(2); else DSA_OUT(3);
#undef DSA_OUT
        lds_fence();
    }
}

DI void dsa_kpass(int t, int g, const bf16_t* Q, const unsigned char* K8, const unsigned short* SEL, const int* NSEL, unsigned char* P8, float* LS, LAS unsigned char* sl, int lane) {
    LAS unsigned short* selL = (LAS unsigned short*)sl;
    const int ns = NSEL[t];
    { const u32x2 sv = *(const u32x2*)(SEL + (size_t)t * TOPK + 4 * lane); *(LAS u32x2*)(selL + 4 * lane) = sv; }
    lds_fence();
    const int c = lane & 15, kq = lane >> 4;
    const __amdgpu_buffer_rsrc_t rsK = __builtin_amdgcn_make_buffer_rsrc((void*)uni_ptr((const bf16_t*)K8), (short)0, S * NKV * HD, 0x00020000);
    long qf[4];
#pragma unroll
    for (int u = 0; u < 2; ++u) {
        unsigned zu = 0u; asm volatile("" : "+v"(zu));
        u32x4 q0 = {zu, zu, zu, zu}, q1 = {zu, zu, zu, zu};
        if (c < NH) { const u32x4* qp = (const u32x4*)(Q + ((size_t)t * NH + c) * HD + 64 * u + 16 * kq); q0 = qp[0]; q1 = qp[1]; }
        const u32x2 f0 = pack8_fp8((f32x4){bf_lo(q0.x), bf_hi(q0.x), bf_lo(q0.y), bf_hi(q0.y)}, (f32x4){bf_lo(q0.z), bf_hi(q0.z), bf_lo(q0.w), bf_hi(q0.w)});
        const u32x2 f1 = pack8_fp8((f32x4){bf_lo(q1.x), bf_hi(q1.x), bf_lo(q1.y), bf_hi(q1.y)}, (f32x4){bf_lo(q1.z), bf_hi(q1.z), bf_lo(q1.w), bf_hi(q1.w)});
        qf[2 * u] = mk_i64(f0.x, f0.y); qf[2 * u + 1] = mk_i64(f1.x, f1.y);
    }
    const unsigned gofs = (unsigned)g * HD;
    constexpr int KR = 8;
    u32x4 kr[KR][2];
#define DSA_KLOAD(slot, j) do { const unsigned vo_ = (unsigned)selL[16 * (j) + c] * (NKV * HD) + gofs + 16u * kq; \
    kr[slot][0] = __builtin_bit_cast(u32x4, bload(rsK, vo_, 0u)); kr[slot][1] = __builtin_bit_cast(u32x4, bload(rsK, vo_, 64u)); } while (0)
#pragma unroll
    for (int j = 0; j < KR - 1; ++j) DSA_KLOAD(j, j);
    f32x4 sacc[16];
#pragma unroll
    for (int j = 0; j < 16; ++j) {
        if (j + KR - 1 < 16) DSA_KLOAD((j + KR - 1) % KR, j + KR - 1);
        f32x4 a4 = {0.f, 0.f, 0.f, 0.f};
#pragma unroll
        for (int u = 0; u < 2; ++u) {
            const u32x4 kv = kr[j % KR][u];
            a4 = MFMA16F8(mk_i64(kv.x, kv.y), qf[2 * u], a4);
            a4 = MFMA16F8(mk_i64(kv.z, kv.w), qf[2 * u + 1], a4);
        }
        sacc[j] = a4;
    }
#undef DSA_KLOAD
    __builtin_amdgcn_sched_barrier(0);
    float mx = -__builtin_inff();
    if (ns < TOPK) {
        int nsl = ns - 4 * kq; asm volatile("" : "+v"(nsl));
#pragma unroll
        for (int j = 0; j < 16; ++j)
#pragma unroll
            for (int e = 0; e < 4; ++e) sacc[j][e] = (16 * j + e) < nsl ? sacc[j][e] : -__builtin_inff();
    }
    float mx2 = mx;
#pragma unroll
    for (int j = 0; j < 16; ++j) { mx = vmax3(mx, sacc[j][0], sacc[j][1]); mx2 = vmax3(mx2, sacc[j][2], sacc[j][3]); }
    mx = fmaxf(mx, mx2);
    mx = fmaxf(mx, shx(mx, 16, lane)); mx = fmaxf(mx, shx(mx, 32, lane));
    const float ml = mx * ATT_SC - 8.0f; float l = 0.f;
    u32x4 pst[4];
#pragma unroll
    for (int jj = 0; jj < 8; ++jj) {
        f32x4 p0, p1;
#pragma unroll
        for (int e = 0; e < 4; ++e) { p0[e] = __builtin_amdgcn_exp2f(sacc[2 * jj][e] * ATT_SC - ml); p1[e] = __builtin_amdgcn_exp2f(sacc[2 * jj + 1][e] * ATT_SC - ml); }
        l += ((p0[0] + p0[1]) + (p0[2] + p0[3])) + ((p1[0] + p1[1]) + (p1[2] + p1[3]));
        const u32x2 w = pack8_fp8(p0, p1);
        if (jj & 1) { pst[jj >> 1].z = w.x; pst[jj >> 1].w = w.y; } else { pst[jj >> 1].x = w.x; pst[jj >> 1].y = w.y; }
    }
    l += shx(l, 16, lane); l += shx(l, 32, lane);
    const int a = c - 3 * g;
    if (a >= 0 && a < 3) {
        u32x4* dst = (u32x4*)(P8 + ((((size_t)t * NKV + g) * 3 + a) * 4 + kq) * 64);
#pragma unroll
        for (int i = 0; i < 4; ++i) dst[i] = pst[i];
        if (kq == 0) LS[((size_t)t * NKV + g) * 3 + a] = l;
    }
    lds_fence();
}
DI void dsa_vpass(int t, int g, const unsigned char* V8, const unsigned short* SEL, const unsigned char* P8, const float* LS, bf16_t* AO, LAS unsigned char* vb, LAS unsigned char* sl, int lane) {
    LAS unsigned short* selL = (LAS unsigned short*)sl;
    { const u32x2 sv = *(const u32x2*)(SEL + (size_t)t * TOPK + 4 * lane); *(LAS u32x2*)(selL + 4 * lane) = sv; }
    const int c = lane & 15, kq = lane >> 4, a = c - 3 * g;
    u32x4 pst[4]; unsigned zu = 0u; asm volatile("" : "+v"(zu));
#pragma unroll
    for (int i = 0; i < 4; ++i) pst[i] = (u32x4){zu, zu, zu, zu};
    float lrow = 1.0f;
    if (a >= 0 && a < 3) {
        const u32x4* src = (const u32x4*)(P8 + ((((size_t)t * NKV + g) * 3 + a) * 4 + kq) * 64);
#pragma unroll
        for (int i = 0; i < 4; ++i) pst[i] = src[i];
        lrow = LS[((size_t)t * NKV + g) * 3 + a];
    }
    lds_fence();
    unsigned tra[4];
    {
        const int q = (lane >> 2) & 3, p = lane & 3, sw = ((kq & 1) << 1) | (q >> 1);
#pragma unroll
        for (int db = 0; db < 4; ++db) tra[db] = (unsigned)(unsigned long long)vb + (unsigned)((4 * kq + q) * 128 + ((((db ^ sw) << 1) | (p >> 1)) << 4) + 8 * (p & 1));
    }
    const int dch = ((lane & 7) ^ (((lane >> 4) & 3) << 1)) * 16;
    const unsigned gofs = (unsigned)g * HD;
#define DSA_VDMA(kb) do { const unsigned key_ = (unsigned)selL[8 * (kb) + (lane >> 3)]; \
    __builtin_amdgcn_global_load_lds((const unsigned*)(V8 + (size_t)key_ * (NKV * HD) + gofs + dch), (LAS unsigned*)(vb + ((kb) & 15) * 1024), 16, 0, 0); } while (0)
#pragma unroll
    for (int kb = 0; kb < 16; ++kb) DSA_VDMA(kb);
    long pa[8];
#pragma unroll
    for (int i = 0; i < 4; ++i) { pa[2 * i] = mk_i64(pst[i].x, pst[i].y); pa[2 * i + 1] = mk_i64(pst[i].z, pst[i].w); }
    f32x4 oe[4], oo[4];
#pragma unroll
    for (int db = 0; db < 4; ++db) { oe[db] = (f32x4){0.f, 0.f, 0.f, 0.f}; oo[db] = (f32x4){0.f, 0.f, 0.f, 0.f}; }
#pragma unroll
    for (int ch = 0; ch < 4; ++ch) {
        if (ch < 3) asm volatile("s_waitcnt vmcnt(8)" ::: "memory"); else asm volatile("s_waitcnt vmcnt(0)" ::: "memory");
#pragma unroll
        for (int j2 = 0; j2 < 2; ++j2) {
            u32x2 r[8];
            if ((ch & 1) == 0) { if (j2 == 0) DSA_TR8(r[0], r[1], r[2], r[3], r[4], r[5], r[6], r[7], tra[0], tra[1], tra[2], tra[3], 0); else DSA_TR8(r[0], r[1], r[2], r[3], r[4], r[5], r[6], r[7], tra[0], tra[1], tra[2], tra[3], 4096); }
            else { if (j2 == 0) DSA_TR8(r[0], r[1], r[2], r[3], r[4], r[5], r[6], r[7], tra[0], tra[1], tra[2], tra[3], 8192); else DSA_TR8(r[0], r[1], r[2], r[3], r[4], r[5], r[6], r[7], tra[0], tra[1], tra[2], tra[3], 12288); }
#pragma unroll
            for (int db = 0; db < 4; ++db) {
                const u32x2 x = r[2 * db], y = r[2 * db + 1];
                const unsigned elo = __builtin_amdgcn_perm(x.y, x.x, 0x06040200u), ehi = __builtin_amdgcn_perm(y.y, y.x, 0x06040200u);
                const unsigned olo = __builtin_amdgcn_perm(x.y, x.x, 0x07050301u), ohi = __builtin_amdgcn_perm(y.y, y.x, 0x07050301u);
                oe[db] = MFMA16F8(pa[2 * ch + j2], mk_i64(elo, ehi), oe[db]);
                oo[db] = MFMA16F8(pa[2 * ch + j2], mk_i64(olo, ohi), oo[db]);
            }
        }
        if (ch < 2) {
#pragma unroll
            for (int kb = 0; kb < 8; ++kb) DSA_VDMA(16 + 8 * ch + kb);
        }
    }
#undef DSA_VDMA
#define DSA_OUT(GG) do { _Pragma("unroll") for (int a_ = 0; a_ < 3; ++a_) { const int h = 3 * (GG) + a_; \
        const float iv = 1.0f / __int_as_float(__builtin_amdgcn_readlane(__float_as_int(lrow), h));   \
        if (kq == (h >> 2)) { _Pragma("unroll") for (int db = 0; db < 4; ++db) \
            *(unsigned*)(AO + (size_t)t * D + h * HD + 32 * db + 2 * c) = pk_bf16(oe[db][h & 3] * iv, oo[db][h & 3] * iv); } } } while (0)
    if (g == 0) DSA_OUT(0); else if (g == 1) DSA_OUT(1); else if (g == 2) DSA_OUT(2); else DSA_OUT(3);
#undef DSA_OUT
    lds_fence();
}

#ifndef PROBE_VDMA2
#define PROBE_VDMA2 0
#endif
DI void dsa_phase(const bf16_t* Q, const unsigned char* K8, const unsigned char* V8, const unsigned short* SEL, const int* NSEL, bf16_t* AO, LAS unsigned char* vb, LAS unsigned char* sl, int gw, int W, int lane) {
    const int c = lane & 15, kq = lane >> 4;
    const __amdgpu_buffer_rsrc_t rsK = __builtin_amdgcn_make_buffer_rsrc((void*)uni_ptr((const bf16_t*)K8), (short)0, S * NKV * HD, 0x00020000);
    unsigned tra[4];
    {
        const int q = (lane >> 2) & 3, p = lane & 3, sw = ((kq & 1) << 1) | (q >> 1);
#pragma unroll
        for (int db = 0; db < 4; ++db) tra[db] = (unsigned)(unsigned long long)vb + (unsigned)((4 * kq + q) * 128 + ((((db ^ sw) << 1) | (p >> 1)) << 4) + 8 * (p & 1));
    }
    const int dch = ((lane & 7) ^ (((lane >> 4) & 3) << 1)) * 16;
    int t = gw;
    if (t >= S) return;
    LAS unsigned short* selC = (LAS unsigned short*)sl;
    LAS unsigned short* selN = selC + 256;
    { const u32x2 sv = *(const u32x2*)(SEL + (size_t)t * TOPK + 4 * lane); *(LAS u32x2*)(selC + 4 * lane) = sv; }
    int ns = NSEL[t];
    lds_fence();
    long qf[4];
#define DSA_QCVT(q0, q1, u) do { const u32x2 f0_ = pack8_fp8((f32x4){bf_lo(q0.x), bf_hi(q0.x), bf_lo(q0.y), bf_hi(q0.y)}, (f32x4){bf_lo(q0.z), bf_hi(q0.z), bf_lo(q0.w), bf_hi(q0.w)}); \
        const u32x2 f1_ = pack8_fp8((f32x4){bf_lo(q1.x), bf_hi(q1.x), bf_lo(q1.y), bf_hi(q1.y)}, (f32x4){bf_lo(q1.z), bf_hi(q1.z), bf_lo(q1.w), bf_hi(q1.w)}); \
        qf[2 * (u)] = mk_i64(f0_.x, f0_.y); qf[2 * (u) + 1] = mk_i64(f1_.x, f1_.y); } while (0)
    const int cq = c < NH ? c : 0;
    {
#pragma unroll
        for (int u = 0; u < 2; ++u) { const u32x4* qp = (const u32x4*)(Q + ((size_t)t * NH + cq) * HD + 64 * u + 16 * kq); const u32x4 q0 = qp[0], q1 = qp[1]; DSA_QCVT(q0, q1, u); }
    }
    constexpr int KR = 8;
    u32x4 kr[KR][2];
#define DSA_KLOAD(slot, j, selp, gofs_) do { const unsigned vo_ = (unsigned)(selp)[16 * (j) + c] * (NKV * HD) + (gofs_) + 16u * kq; \
        kr[slot][0] = __builtin_bit_cast(u32x4, bload(rsK, vo_, 0u)); kr[slot][1] = __builtin_bit_cast(u32x4, bload(rsK, vo_, 64u)); } while (0)
#define DSA_VDMA(kb, selp, gofs_) do { const unsigned key_ = (unsigned)(selp)[8 * (kb) + (lane >> 3)] & (unsigned)(S - 1); \
        __builtin_amdgcn_global_load_lds((const unsigned*)(V8 + (size_t)key_ * (NKV * HD) + (gofs_) + dch), (LAS unsigned*)(vb + ((kb) & 15) * 1024), 16, 0, 0); \
        if (PROBE_VDMA2) __builtin_amdgcn_global_load_lds((const unsigned*)(V8 + (size_t)(key_ ^ 1u) * (NKV * HD) + (gofs_) + dch), (LAS unsigned*)(sl - (gw & 7) * 1024 + 8192), 16, 0, 0); } while (0)
#pragma unroll
    for (int j = 0; j < KR - 1; ++j) DSA_KLOAD(j, j, selC, 0u);
#pragma unroll
    for (int kb = 0; kb < 16; ++kb) DSA_VDMA(kb, selC, 0u);
    for (;;) {
        const int tn = t + W; const bool has_next = tn < S;
        u32x2 svn = {0u, 0u}; int nsn = 0; u32x4 qr[4] = {{0u, 0u, 0u, 0u}, {0u, 0u, 0u, 0u}, {0u, 0u, 0u, 0u}, {0u, 0u, 0u, 0u}};
        if (has_next) {
            svn = *(const u32x2*)(SEL + (size_t)tn * TOPK + 4 * lane); nsn = NSEL[tn];
#pragma unroll
            for (int u = 0; u < 2; ++u) { const u32x4* qp = (const u32x4*)(Q + ((size_t)tn * NH + cq) * HD + 64 * u + 16 * kq); qr[2 * u] = qp[0]; qr[2 * u + 1] = qp[1]; }
        }
#pragma unroll 1
        for (int g = 0; g < NKV; ++g) {
            const unsigned gofs = (unsigned)g * HD;
            const bool more = g < NKV - 1 || has_next;
            LAS const unsigned short* selX = g < NKV - 1 ? selC : selN; const unsigned gofsX = g < NKV - 1 ? gofs + HD : 0u;
            f32x4 sacc[16];
#pragma unroll
            for (int j = 0; j < 16; ++j) {
                if (j + KR - 1 < 16) DSA_KLOAD((j + KR - 1) % KR, j + KR - 1, selC, gofs);
                f32x4 a4 = {0.f, 0.f, 0.f, 0.f};
#pragma unroll
                for (int u = 0; u < 2; ++u) {
                    const u32x4 kv = kr[j % KR][u];
                    a4 = MFMA16F8(mk_i64(kv.x, kv.y), qf[2 * u], a4);
                    a4 = MFMA16F8(mk_i64(kv.z, kv.w), qf[2 * u + 1], a4);
                }
                sacc[j] = a4;
            }
            if (g == 1 && has_next) { *(LAS u32x2*)(selN + 4 * lane) = svn; lds_fence(); }
            if (more) {
#pragma unroll
                for (int j = 0; j < KR - 1; ++j) DSA_KLOAD(j, j, selX, gofsX);
            }
            float mx = -__builtin_inff();
            int nsl = ns - 4 * kq; asm volatile("" : "+v"(nsl));
#pragma unroll
            for (int j = 0; j < 16; ++j)
#pragma unroll
                for (int e = 0; e < 4; ++e) { const float s_ = (16 * j + e) < nsl ? sacc[j][e] : -__builtin_inff(); sacc[j][e] = s_; mx = fmaxf(mx, s_); }
            mx = fmaxf(mx, shx(mx, 16, lane)); mx = fmaxf(mx, shx(mx, 32, lane));
            const float ml = mx * ATT_SC - 8.0f; float l = 0.f;
            long pa[8];
#pragma unroll
            for (int jj = 0; jj < 8; ++jj) {
                f32x4 p0, p1;
#pragma unroll
                for (int e = 0; e < 4; ++e) { p0[e] = __builtin_amdgcn_exp2f(sacc[2 * jj][e] * ATT_SC - ml); p1[e] = __builtin_amdgcn_exp2f(sacc[2 * jj + 1][e] * ATT_SC - ml); }
                l += ((p0[0] + p0[1]) + (p0[2] + p0[3])) + ((p1[0] + p1[1]) + (p1[2] + p1[3]));
                const u32x2 w = pack8_fp8(p0, p1);
                pa[jj] = mk_i64(w.x, w.y);
            }
            l += shx(l, 16, lane); l += shx(l, 32, lane);
            f32x4 oe[4], oo[4];
#pragma unroll
            for (int db = 0; db < 4; ++db) { oe[db] = (f32x4){0.f, 0.f, 0.f, 0.f}; oo[db] = (f32x4){0.f, 0.f, 0.f, 0.f}; }
#pragma unroll
            for (int ch = 0; ch < 4; ++ch) {
                if (ch == 0) asm volatile("s_waitcnt vmcnt(26)" ::: "memory");
                else if (ch == 2) { if (PROBE_VDMA2) asm volatile("s_waitcnt vmcnt(16)" ::: "memory"); else asm volatile("s_waitcnt vmcnt(8)" ::: "memory"); }
                else if (ch == 3) { if (more) { if (PROBE_VDMA2) asm volatile("s_waitcnt vmcnt(16)" ::: "memory"); else asm volatile("s_waitcnt vmcnt(8)" ::: "memory"); } else asm volatile("s_waitcnt vmcnt(0)" ::: "memory"); }
#pragma unroll
                for (int j2 = 0; j2 < 2; ++j2) {
                    u32x2 r[8];
                    if ((ch & 1) == 0) { if (j2 == 0) DSA_TR8(r[0], r[1], r[2], r[3], r[4], r[5], r[6], r[7], tra[0], tra[1], tra[2], tra[3], 0); else DSA_TR8(r[0], r[1], r[2], r[3], r[4], r[5], r[6], r[7], tra[0], tra[1], tra[2], tra[3], 4096); }
                    else { if (j2 == 0) DSA_TR8(r[0], r[1], r[2], r[3], r[4], r[5], r[6], r[7], tra[0], tra[1], tra[2], tra[3], 8192); else DSA_TR8(r[0], r[1], r[2], r[3], r[4], r[5], r[6], r[7], tra[0], tra[1], tra[2], tra[3], 12288); }
#pragma unroll
                    for (int db = 0; db < 4; ++db) {
                        const u32x2 x = r[2 * db], y = r[2 * db + 1];
                        const unsigned elo = __builtin_amdgcn_perm(x.y, x.x, 0x06040200u), ehi = __builtin_amdgcn_perm(y.y, y.x, 0x06040200u);
                        const unsigned olo = __builtin_amdgcn_perm(x.y, x.x, 0x07050301u), ohi = __builtin_amdgcn_perm(y.y, y.x, 0x07050301u);
                        oe[db] = MFMA16F8(pa[2 * ch + j2], mk_i64(elo, ehi), oe[db]);
                        oo[db] = MFMA16F8(pa[2 * ch + j2], mk_i64(olo, ohi), oo[db]);
                    }
                }
                if (ch < 2) {
#pragma unroll
                    for (int kb = 0; kb < 8; ++kb) DSA_VDMA(16 + 8 * ch + kb, selC, gofs);
                } else if (more) {
#pragma unroll
                    for (int kb = 0; kb < 8; ++kb) DSA_VDMA(8 * (ch - 2) + kb, selX, gofsX);
                }
            }
#pragma unroll
            for (int a = 0; a < 3; ++a) {
                const int h = 3 * g + a, he = h & 3;
                const float iv = 1.0f / __int_as_float(__builtin_amdgcn_readlane(__float_as_int(l), h));
                if (kq == (h >> 2)) {
#pragma unroll
                    for (int db = 0; db < 4; ++db) {
                        const float ve = he == 0 ? oe[db][0] : he == 1 ? oe[db][1] : he == 2 ? oe[db][2] : oe[db][3];
                        const float vo = he == 0 ? oo[db][0] : he == 1 ? oo[db][1] : he == 2 ? oo[db][2] : oo[db][3];
                        *(unsigned*)(AO + (size_t)t * D + h * HD + 32 * db + 2 * c) = pk_bf16(ve * iv, vo * iv);
                    }
                }
            }
        }
        if (!has_next) break;
        t = tn; ns = nsn;
        { LAS unsigned short* x_ = selC; selC = selN; selN = x_; }
        DSA_QCVT(qr[0], qr[1], 0); DSA_QCVT(qr[2], qr[3], 1);
    }
#undef DSA_KLOAD
#undef DSA_VDMA
#undef DSA_QCVT
}

DI void moba_gate_unit(int unit, const bf16_t* Q, const float* KMEAN, unsigned short* ITEMS, int* NITEMS, int* IB, LAS unsigned char* lds, int tid) {
    const int cur = unit >> 2, g = unit & 3, nv = cur < 3 ? cur : 3;
    LAS float* km = (LAS float*)lds;
    LAS int* bcnt = (LAS int*)(lds + 32768);
    LAS int* boff = bcnt + 64;
    LAS int* ibase = boff + 64;
    LAS int* bfill = ibase + 68;
    LAS unsigned* rowsel = (LAS unsigned*)(bfill + 64);
    LAS unsigned short* sorted = (LAS unsigned short*)(rowsel + 768);
    if (tid < 64) { bcnt[tid] = 0; bfill[tid] = 0; }
    for (int i = tid; i < cur * 32; i += NTHREADS) *(LAS f32x4*)(km + 4 * i) = *(const f32x4*)(KMEAN + (size_t)g * NBLK * HD + 4 * i);
    __syncthreads();
    if (nv > 0) {
        for (int row = tid; row < 768; row += NTHREADS) {
            const int tl = row / 3, rr = row - 3 * tl, t = cur * MBLK + tl;
            const u32x4* qp = (const u32x4*)(Q + ((size_t)t * NH + 3 * g + rr) * HD);
            u32x4 qv[16];
#pragma unroll
            for (int i = 0; i < 16; ++i) qv[i] = qp[i];
            float v0 = -__builtin_inff(), v1 = v0, v2 = v0; int i0 = 0, i1 = 0, i2 = 0;
            for (int n = 0; n < cur; ++n) {
                float dot = 0.f;
#pragma unroll
                for (int i = 0; i < 16; ++i) {
                    const f32x4 ka = *(const LAS f32x4*)(km + n * HD + 8 * i), kb = *(const LAS f32x4*)(km + n * HD + 8 * i + 4);
                    dot = fmaf(bf_lo(qv[i].x), ka[0], dot); dot = fmaf(bf_hi(qv[i].x), ka[1], dot); dot = fmaf(bf_lo(qv[i].y), ka[2], dot); dot = fmaf(bf_hi(qv[i].y), ka[3], dot);
                    dot = fmaf(bf_lo(qv[i].z), kb[0], dot); dot = fmaf(bf_hi(qv[i].z), kb[1], dot); dot = fmaf(bf_lo(qv[i].w), kb[2], dot); dot = fmaf(bf_hi(qv[i].w), kb[3], dot);
                }
                if (dot > v0) { v2 = v1; i2 = i1; v1 = v0; i1 = i0; v0 = dot; i0 = n; }
                else if (dot > v1) { v2 = v1; i2 = i1; v1 = dot; i1 = n; }
                else if (dot > v2) { v2 = dot; i2 = n; }
            }
            rowsel[row] = (unsigned)i0 | ((unsigned)i1 << 8) | ((unsigned)i2 << 16);
            atomicAdd((int*)(bcnt + i0), 1); if (nv > 1) atomicAdd((int*)(bcnt + i1), 1); if (nv > 2) atomicAdd((int*)(bcnt + i2), 1);
        }
    }
    __syncthreads();
    if (tid == 0) { int o = 0, ib = 0; for (int n = 0; n < 64; ++n) { boff[n] = o; ibase[n] = ib; const int c = n < cur ? bcnt[n] : 0; o += c; ib += (c + 31) >> 5; } ibase[64] = ib; }
    __syncthreads();
    if (nv > 0) {
        for (int row = tid; row < 768; row += NTHREADS) {
            const int tl = row / 3, rr = row - 3 * tl; const unsigned rs = rowsel[row];
            for (int j = 0; j < nv; ++j) { const int n = (rs >> (8 * j)) & 255; const int pos = atomicAdd((int*)(bfill + n), 1); sorted[boff[n] + pos] = (unsigned short)((tl << 4) | (rr << 2) | j); }
        }
    }
    __syncthreads();
    const int wave = tid >> 6, lane = tid & 63;
    unsigned short* ib = ITEMS + (size_t)unit * ITEM_CAP * ITEM_U16;
    for (int n = wave; n < cur; n += NWAVES) {
        const int c = bcnt[n], b0 = ibase[n], o0 = boff[n];
        for (int i = lane; i < c; i += 64) ib[(size_t)(b0 + (i >> 5)) * ITEM_U16 + 8 + (i & 31)] = sorted[o0 + i];
        for (int k = lane; k < ((c + 31) >> 5); k += 64) { ib[(size_t)(b0 + k) * ITEM_U16] = (unsigned short)n; const int rem = c - 32 * k; ib[(size_t)(b0 + k) * ITEM_U16 + 1] = (unsigned short)(rem < 32 ? rem : 32); }
    }
    if (tid == 0) NITEMS[unit] = ibase[64];
    if (tid < 65) IB[unit * 68 + tid] = ibase[tid];
    __syncthreads();
}

DI void moba_item(int unit, int k, const bf16_t* Q, const bf16_t* KBLK, const bf16_t* VT, const unsigned short* ITEMS, const int* NITEMS, bf16_t* PO, float* PML, int lane) {
    const int cur = unit >> 2, g = unit & 3, r = lane & 31, h = lane >> 5;
    int n, count, tl, rr, j; bool causal;
    if (k < ITEM_CAP) {
        if (k >= NITEMS[unit]) return;
        const unsigned short* it = ITEMS + ((size_t)unit * ITEM_CAP + k) * ITEM_U16;
        n = it[0]; count = it[1];
        const unsigned rec = it[8 + (r < count ? r : 0)];
        tl = rec >> 4; rr = (rec >> 2) & 3; j = rec & 3; causal = false;
    } else {
        const int rho = 32 * (k - ITEM_CAP) + r;
        n = cur; count = 32; tl = rho / 3; rr = rho - 3 * tl; j = 3; causal = true;
    }
    const int t = cur * MBLK + tl, hq = 3 * g + rr;
    f32x16 oacc[4]; float mlog, l;
    n = __builtin_amdgcn_readfirstlane(n);
    attn_item(Q + ((size_t)t * NH + hq) * HD, KBLK + (size_t)(g * NBLK + n) * HD * MBLK, VT + (size_t)(g * NBLK + n) * HD * MBLK, causal, n * MBLK, t, lane, oacc, mlog, l);
    if (r < count) {
        const size_t slot = ((size_t)t * NH + hq) * 4 + j;
        const float inv = 1.0f / l;
        bf16_t* op = PO + slot * HD;
#pragma unroll
        for (int dt = 0; dt < 4; ++dt)
#pragma unroll
            for (int q4 = 0; q4 < 4; ++q4) {
                u32x2 w; w.x = pk_bf16(oacc[dt][4 * q4] * inv, oacc[dt][4 * q4 + 1] * inv); w.y = pk_bf16(oacc[dt][4 * q4 + 2] * inv, oacc[dt][4 * q4 + 3] * inv);
                *(u32x2*)(op + 32 * dt + 8 * q4 + 4 * h) = w;
            }
        if (h == 0) { f32x2 ml = {mlog, l}; *(f32x2*)(PML + slot * 2) = ml; }
    }
}

DI void attn_qk_lds(const bf16x8 (&qf)[8], LAS const unsigned char* ldsK, int lane, f32x16 (&sacc)[8]) {
#pragma unroll
    for (int mt = 0; mt < 8; ++mt) {
#pragma unroll
        for (int j = 0; j < 16; ++j) sacc[mt][j] = 0.f;
#pragma unroll
        for (int ks = 0; ks < 8; ++ks) { const bf16x8 a = *(LAS const bf16x8*)(ldsK + (mt * 8 + ks) * 1024 + lane * 16); sacc[mt] = MFMA32(a, qf[ks], sacc[mt]); }
    }
}
DI void attn_sm_lds(f32x16 (&sacc)[8], bool causal, int kbase, int tq, int lane, u32x4 (&pw)[8][2], float& mlog, float& lsum) {
    const int h = lane >> 5;
    float mx = -__builtin_inff();
    if (causal) {
        const int lim = tq - kbase - 4 * h;
#pragma unroll
        for (int mt = 0; mt < 8; ++mt)
#pragma unroll
            for (int j = 0; j < 16; ++j) sacc[mt][j] = (32 * mt + (j & 3) + 8 * (j >> 2)) > lim ? -__builtin_inff() : sacc[mt][j];
    }
    float mx2 = mx;
#pragma unroll
    for (int mt = 0; mt < 8; ++mt)
#pragma unroll
        for (int j = 0; j < 16; j += 4) { mx = vmax3(mx, sacc[mt][j], sacc[mt][j + 1]); mx2 = vmax3(mx2, sacc[mt][j + 2], sacc[mt][j + 3]); }
    mx = fmaxf(mx, mx2);
    mx = fmaxf(mx, shx(mx, 32, lane));
    mlog = mx * ATT_SC;
    float l = 0.f;
#pragma unroll
    for (int mt = 0; mt < 8; ++mt)
#pragma unroll
        for (int s2 = 0; s2 < 2; ++s2) {
            float p[8];
#pragma unroll
            for (int j = 0; j < 8; ++j) { p[j] = __builtin_amdgcn_exp2f(sacc[mt][8 * s2 + j] * ATT_SC - mlog); l += p[j]; }
            pw[mt][s2].x = pk_bf16(p[0], p[1]); pw[mt][s2].y = pk_bf16(p[2], p[3]); pw[mt][s2].z = pk_bf16(p[4], p[5]); pw[mt][s2].w = pk_bf16(p[6], p[7]);
        }
    l += shx(l, 32, lane);
    lsum = l;
}
DI void attn_pv_lds(const u32x4 (&pw)[8][2], LAS const unsigned char* ldsV, int lane, f32x16 (&oacc)[4]) {
#pragma unroll
    for (int dt = 0; dt < 4; ++dt)
#pragma unroll
        for (int j = 0; j < 16; ++j) oacc[dt][j] = 0.f;
#pragma unroll
    for (int mt = 0; mt < 8; ++mt)
#pragma unroll
        for (int s2 = 0; s2 < 2; ++s2) {
            const bf16x8 pb = __builtin_bit_cast(bf16x8, pw[mt][s2]);
#pragma unroll
            for (int dt = 0; dt < 4; ++dt) { const bf16x8 a = *(LAS const bf16x8*)(ldsV + (((dt * 8 + mt) * 2) + s2) * 1024 + lane * 16); oacc[dt] = MFMA32(a, pb, oacc[dt]); }
        }
}
#ifndef MOBA_DESYNC
#define MOBA_DESYNC 0
#endif
#ifndef MOBA_TOUCH
#define MOBA_TOUCH 1
#endif
constexpr int MPART = 32;
DI void moba_phase_lds(const bf16_t* Q, const bf16_t* KBLK, const bf16_t* VTB, const unsigned short* ITEMS, const int* IB, bf16_t* PO, float* PML, LAS unsigned char* lds, int tid, int bid, int G) {
    const int lane = tid & 63, wave = __builtin_amdgcn_readfirstlane(tid >> 6), r = lane & 31, h = lane >> 5;
    LAS int* Tt = (LAS int*)(lds + STAGE_LDS + 1024);
    LAS int* Ts = Tt + 256;
    LAS int* PP = Ts + 256;
    if (tid < 256) {
        const int g = tid >> 6, n = tid & 63; int ts = 0;
        for (int cur = n + 1; cur < NBLK; ++cur) { const int* ib = IB + (cur * 4 + g) * 68; ts += ib[n + 1] - ib[n]; }
        Ts[tid] = ts; Tt[tid] = ts + OWN_ITEMS;
    }
    __syncthreads();
    if (tid == 0) { int p = 0; for (int i = 0; i < 256; ++i) { PP[i] = p; p += (Tt[i] + MPART - 1) / MPART; } PP[256] = p; }
    __syncthreads();
    const int P = PP[256];
    for (int p = bid; p < P; p += G) {
        int lo_ = 0, hi_ = 256;
        while (hi_ - lo_ > 1) { const int mid = (lo_ + hi_) >> 1; if (PP[mid] <= p) lo_ = mid; else hi_ = mid; }
        const int task = __builtin_amdgcn_readfirstlane(lo_), g = task >> 6, n = task & 63;
        const int q0 = (p - PP[task]) * MPART, Tsel = Ts[task], Ttot = Tt[task];
        {
            const u32x4* ksrc = (const u32x4*)(KBLK + (size_t)(g * NBLK + n) * HD * MBLK); const u32x4* vsrc = (const u32x4*)(VTB + (size_t)(g * NBLK + n) * HD * MBLK);
            u32x4 kt[8], vt[8];
            int tid_s = tid; asm volatile("" : "+v"(tid_s));
#pragma unroll
            for (int i = 0; i < 8; ++i) { kt[i] = ksrc[tid_s + 512 * i]; vt[i] = vsrc[tid_s + 512 * i]; }
#pragma unroll
            for (int i = 0; i < 8; ++i) { ((LAS u32x4*)lds)[tid_s + 512 * i] = kt[i]; ((LAS u32x4*)(lds + 65536))[tid_s + 512 * i] = vt[i]; }
        }
        int cnt_l = 0, ib_l = 0;
        { const int cur_l = n + 1 + lane; if (cur_l < NBLK) { const int* ib = IB + (cur_l * 4 + g) * 68; ib_l = ib[n]; cnt_l = ib[n + 1] - ib_l; } }
        int incl = cnt_l;
        int lane_s = lane; asm volatile("" : "+v"(lane_s));
#pragma unroll
        for (int o = 1; o < 64; o <<= 1) { const int v = __builtin_amdgcn_ds_bpermute((lane_s - o) << 2, incl); if (lane_s >= o) incl += v; }
        const int excl = incl - cnt_l;
        __syncthreads();
#define MOBA_ITEM(q_, OWN, COUNT, CUR, REC) do { int k_; \
            if ((q_) < Tsel) { const unsigned long long m_ = __ballot(excl <= (q_) && (q_) < incl); const int src_ = __builtin_ctzll(m_); \
                CUR = n + 1 + src_; k_ = __builtin_amdgcn_readlane(ib_l, src_) + ((q_) - __builtin_amdgcn_readlane(excl, src_)); OWN = false; } \
            else { CUR = n; k_ = (q_) - Tsel; OWN = true; } \
            if (!OWN) { const unsigned short* it_ = ITEMS + ((size_t)(CUR * 4 + g) * ITEM_CAP + k_) * ITEM_U16; COUNT = __builtin_amdgcn_readfirstlane((int)it_[1]); \
                REC = it_[8 + (r < COUNT ? r : 0)]; } \
            else { const int rho_ = 32 * k_ + r, tl_ = rho_ / 3; COUNT = 32; REC = (unsigned)((tl_ << 4) | ((rho_ - 3 * tl_) << 2) | 3); } } while (0)
#define MOBA_QLOAD(CUR, REC) do { const bf16_t* qrow_ = Q + ((size_t)((CUR) * MBLK + (int)((REC) >> 4)) * NH + 3 * g + (int)(((REC) >> 2) & 3)) * HD; \
            _Pragma("unroll") for (int ks = 0; ks < 8; ++ks) qf[ks] = *(const bf16x8*)(qrow_ + 16 * ks + 8 * h); } while (0)
        if (MOBA_DESYNC && wave >= 4) { __builtin_amdgcn_s_sleep(MOBA_DESYNC); __builtin_amdgcn_s_sleep(MOBA_DESYNC); }
        int q = q0 + wave;
        bool own = false; int count = 0, cur = 0; unsigned rec = 0u;
        bf16x8 qf[8];
        if (q < Ttot) { MOBA_ITEM(q, own, count, cur, rec); MOBA_QLOAD(cur, rec); }
        for (int j = 0; j < MPART / NWAVES; ++j) {
            if (q >= Ttot) break;
            const int qn = q + NWAVES; const bool hasn = (j + 1 < MPART / NWAVES) && qn < Ttot;
            bool ownn = false; int countn = 0, curn = 0; unsigned recn = 0u;
            if (hasn) MOBA_ITEM(qn, ownn, countn, curn, recn);
            __builtin_amdgcn_sched_barrier(0);
            f32x16 sacc[8];
            attn_qk_lds(qf, (LAS const unsigned char*)lds, lane, sacc);
            __builtin_amdgcn_sched_barrier(0);
            u32x4 pw[8][2]; float mlog, l;
            const int t = cur * MBLK + (int)(rec >> 4);
            attn_sm_lds(sacc, own, n * MBLK, t, lane, pw, mlog, l);
            __builtin_amdgcn_sched_barrier(0);
            if (hasn) MOBA_QLOAD(curn, recn);
            __builtin_amdgcn_sched_barrier(0);
            f32x16 oacc[4];
            attn_pv_lds(pw, (LAS const unsigned char*)(lds + 65536), lane, oacc);
            if (r < count) {
                const size_t slot = ((size_t)t * NH + 3 * g + (int)((rec >> 2) & 3)) * 4 + (rec & 3);
                const float inv = 1.0f / l;
                bf16_t* op = PO + slot * HD;
#pragma unroll
                for (int dt = 0; dt < 4; ++dt)
#pragma unroll
                    for (int q4 = 0; q4 < 4; ++q4) {
                        u32x2 w; w.x = pk_bf16(oacc[dt][4 * q4] * inv, oacc[dt][4 * q4 + 1] * inv); w.y = pk_bf16(oacc[dt][4 * q4 + 2] * inv, oacc[dt][4 * q4 + 3] * inv);
                        *(u32x2*)(op + 32 * dt + 8 * q4 + 4 * h) = w;
                    }
                if (h == 0) { f32x2 ml = {mlog, l}; *(f32x2*)(PML + slot * 2) = ml; }
            }
            __builtin_amdgcn_sched_barrier(0);
            own = ownn; count = countn; cur = curn; rec = recn; q = qn;
        }
#undef MOBA_ITEM
#undef MOBA_QLOAD
        __syncthreads();
    }
}

DI void moba_merge(const bf16_t* PO, const float* PML, bf16_t* AO, int gtid, int GT) {
    for (int it = gtid; it < S * NH * 16; it += GT) {
        const int c = it & 15, th = it >> 4, t = th / NH, hq = th - t * NH;
        const int cur = t >> 8, nv = cur < 3 ? cur : 3;
        float mj[4], lj[4]; float M = -__builtin_inff();
#pragma unroll
        for (int j = 0; j < 4; ++j) {
            const bool valid = (j == 3) || (j < nv);
            const f32x2 ml = valid ? *(const f32x2*)(PML + ((size_t)th * 4 + j) * 2) : (f32x2){-__builtin_inff(), 0.f};
            mj[j] = ml[0]; lj[j] = ml[1]; M = fmaxf(M, mj[j]);
        }
        float o[8], wsum = 0.f;
#pragma unroll
        for (int e = 0; e < 8; ++e) o[e] = 0.f;
#pragma unroll
        for (int j = 0; j < 4; ++j) {
            const bool valid = (j == 3) || (j < nv);
            if (valid) {
                const float w = lj[j] * __builtin_amdgcn_exp2f(mj[j] - M); wsum += w;
                const u32x4 v = *(const u32x4*)(PO + ((size_t)th * 4 + j) * HD + 8 * c);
                o[0] = fmaf(w, bf_lo(v.x), o[0]); o[1] = fmaf(w, bf_hi(v.x), o[1]); o[2] = fmaf(w, bf_lo(v.y), o[2]); o[3] = fmaf(w, bf_hi(v.y), o[3]);
                o[4] = fmaf(w, bf_lo(v.z), o[4]); o[5] = fmaf(w, bf_hi(v.z), o[5]); o[6] = fmaf(w, bf_lo(v.w), o[6]); o[7] = fmaf(w, bf_hi(v.w), o[7]);
            }
        }
        const float inv = 1.0f / wsum;
        u32x4 w; w.x = pk_bf16(o[0] * inv, o[1] * inv); w.y = pk_bf16(o[2] * inv, o[3] * inv); w.z = pk_bf16(o[4] * inv, o[5] * inv); w.w = pk_bf16(o[6] * inv, o[7] * inv);
        *(u32x4*)(AO + (size_t)t * D + hq * HD + 8 * c) = w;
    }
}
#ifndef MK_ONE_LAUNCH
#define MK_ONE_LAUNCH 1
#endif
#ifndef FP8_MASK
#define FP8_MASK 0xE
#endif
#ifndef DN8_MASK
#define DN8_MASK 0xE
#endif
#ifndef MEMKV_IN_PROJ
#define MEMKV_IN_PROJ 0
#endif
#ifndef IDXDSA_FUSED
#define IDXDSA_FUSED 0
#endif
#ifndef REP_ALL
#define REP_ALL 1
#endif
#ifndef REP_CONV
#define REP_CONV 1
#endif
#ifndef REP_NORM
#define REP_NORM 1
#endif
#ifndef REP_IDX
#define REP_IDX 1
#endif
#ifndef REP_DSA
#define REP_DSA 1
#endif
#ifndef REP_M2
#define REP_M2 1
#endif
#ifndef REP_GU
#define REP_GU 1
#endif
#ifndef REP_M1
#define REP_M1 1
#endif
#ifndef REP_MERGE
#define REP_MERGE 1
#endif
#ifndef REP_PROJ
#define REP_PROJ 1
#endif
#ifndef REP_DOWN
#define REP_DOWN 1
#endif
#ifndef REP_KVPOST
#define REP_KVPOST 1
#endif
#ifndef REP_WOUT
#define REP_WOUT 1
#endif
#ifndef REP_PROJB
#define REP_PROJB 1
#endif
#ifndef REP_FINAL
#define REP_FINAL 1
#endif
#ifndef REP_BAR
#define REP_BAR 1
#endif
struct Args {
    const float* in[19]; float* out; unsigned char* ws; int ph_lo, ph_hi;
};
static_assert(sizeof(Args) == 176, "Args layout");
enum { I_X = 0, I_MEM, I_POS, I_F1N, I_F1GU, I_F1DN, I_ATN, I_MEMN, I_AWIN, I_IKN, I_BWIN, I_WMKV, I_WOUT, I_F2N, I_F2GU, I_F2DN, I_KVN, I_WKV, I_FINN };
#define CAS __attribute__((address_space(4)))

#define RS_PREPASS(so_, ss_) LAS float* RSL = (LAS float*)(lds + STAGE_LDS + 1024); int rowbase = 0; \
    { pg8::Unit u0_; if ((so_).next(0, u0_)) { rowbase = (u0_.pm & ~7) * pg8::BM; rs_prepass((ss_), rowbase, RSL, tid); } else RSL = nullptr; }
#define INP(i) (*(const float* const CAS*)(kp + 8 * (i)))
#define P_COS ((float*)(ws + WS_ROPE))
#define P_SIN ((float*)(ws + WS_ROPE) + (size_t)S * 64)
#define P_H ((bf16_t*)(ws + WS_H))
#define P_H8 ((unsigned char*)(ws + WS_H8))
#define P_ACT ((bf16_t*)(ws + WS_ACT))
#define P_AO ((bf16_t*)(ws + WS_AO))
#define P_AOB ((bf16_t*)X)
#define P_Q ((bf16_t*)(ws + WS_Q))
#define P_K ((bf16_t*)(ws + WS_K))
#define P_V ((bf16_t*)(ws + WS_V))
#define P_QI ((bf16_t*)(ws + WS_QI))
#define P_VT ((bf16_t*)(ws + WS_QI))
#define P_KBLK ((bf16_t*)(ws + WS_QI + (size_t)NKV * NBLK * MBLK * HD * 2))
#define P_KI ((bf16_t*)(ws + WS_KI))
#define P_WI ((float*)(ws + WS_WI))
#define P_QM ((bf16_t*)(ws + WS_QM))
#define P_SEL ((unsigned short*)(ws + WS_SEL))
#define P_NSEL ((int*)(ws + WS_NSEL))
#define P_MEMK ((bf16_t*)(ws + WS_MEMK))
#define P_MEMVT ((bf16_t*)(ws + WS_MEMVT))
#define P_KMEAN ((float*)(ws + WS_KMEAN))
#define P_ITEMS ((unsigned short*)(ws + WS_ITEMS))
#define P_NITEMS ((int*)(ws + WS_NITEMS))
#define P_IB ((int*)(ws + WS_IB))
#define P_PO ((bf16_t*)(ws + WS_PO))
#define P_PML ((float*)(ws + WS_PML))
#define P_WGU(i) ((bf16_t*)(ws + ((i) ? WS_WGU1 : WS_WGU0)))
#define P_WDN(i) ((bf16_t*)(ws + ((i) ? WS_WDN1 : WS_WDN0)))
#define P_WIN ((bf16_t*)(ws + WS_WIN))
#define P_WOUT ((bf16_t*)(ws + WS_WOUT))
#define P_WKV ((bf16_t*)(ws + WS_WKV))
#define P_SS(i) ((float*)(ws + WS_SS) + (size_t)(i) * S * 32)

DI void conv_layer(const CAS char* kp, unsigned char* ws, int L, int bid, int G, int lane, int wave) {
                {
                    constexpr int T_GU = (NGU / 64) * (D / 256), T_DN = (D / 64) * (FF / 256), T_WO = (D / 64) * (D / 256), T_WINA = (NPA / 64) * (D / 256), T_WINB = (B_IN / 64) * (D / 256), T_KV = (KVW / 64) * (D / 256);
                    const int t_in = L == 0 ? T_WINA : T_WINB + T_KV, total = 2 * T_GU + 2 * T_DN + T_WO + t_in;
                    float zf = 0.f; asm volatile("" : "+v"(zf));
#if CONV_WIDE == 1
                    const int kg = wave, nq = lane;
#elif CONV_WIDE == 2
                    const int kg = (lane & 15) + 16 * (wave >> 2), nq = (lane >> 4) + 4 * (wave & 3);
#else
                    const int kg = (lane & 7) + 8 * (wave >> 1), nq = (lane >> 3) + 8 * (wave & 1);
#endif
#define CONV_PICK(J, T) { int t_ = (T); \
                        if (t_ < T_GU) { J.src = INP(I_F1GU) + (size_t)L * D * NGU; J.gain = INP(I_F1N) + (size_t)L * D; J.dst = (unsigned char*)P_WGU(0); J.ld = NGU; J.K = D; J.type = CT_GU; J.fp8 = (FP8_MASK >> (2 * L)) & 1; conv_job_tile(J, t_, NGU / 64); } \
                        else if ((t_ -= T_GU) < T_DN) { J.src = INP(I_F1DN) + (size_t)L * FF * D; J.gain = nullptr; J.dst = (unsigned char*)P_WDN(0); J.ld = D; J.K = FF; J.type = CT_ID; J.fp8 = (DN8_MASK >> (2 * L)) & 1; conv_job_tile(J, t_, D / 64); } \
                        else if ((t_ -= T_DN) < t_in) { \
                            if (L == 0) { J.src = INP(I_AWIN); J.gain = INP(I_ATN); J.dst = (unsigned char*)P_WIN; J.ld = A_IN; J.K = D; J.type = CT_WINA; J.fp8 = 0; conv_job_tile(J, t_, NPA / 64); } \
                            else if (t_ < T_KV) { J.src = INP(I_WKV); J.gain = INP(I_KVN); J.dst = (unsigned char*)P_WKV; J.ld = KVW; J.K = D; J.type = CT_WKV; J.fp8 = 0; conv_job_tile(J, t_, KVW / 64); } \
                            else { J.src = INP(I_BWIN); J.gain = INP(I_ATN) + D; J.dst = (unsigned char*)P_WIN; J.ld = B_IN; J.K = D; J.type = CT_WINB; J.fp8 = 0; conv_job_tile(J, t_ - T_KV, B_IN / 64); } } \
                        else if ((t_ -= t_in) < T_WO) { J.src = INP(I_WOUT) + (size_t)L * D * D; J.gain = nullptr; J.dst = (unsigned char*)P_WOUT; J.ld = D; J.K = D; J.type = CT_ID; J.fp8 = 0; conv_job_tile(J, t_, D / 64); } \
                        else if ((t_ -= T_WO) < T_GU) { J.src = INP(I_F2GU) + (size_t)L * D * NGU; J.gain = INP(I_F2N) + (size_t)L * D; J.dst = (unsigned char*)P_WGU(1); J.ld = NGU; J.K = D; J.type = CT_GU; J.fp8 = (FP8_MASK >> (2 * L + 1)) & 1; conv_job_tile(J, t_, NGU / 64); } \
                        else { t_ -= T_GU; J.src = INP(I_F2DN) + (size_t)L * FF * D; J.gain = nullptr; J.dst = (unsigned char*)P_WDN(1); J.ld = D; J.K = FF; J.type = CT_ID; J.fp8 = (DN8_MASK >> (2 * L + 1)) & 1; conv_job_tile(J, t_, D / 64); } }
                    ConvJob ja, jb; f32x4 va[8], vb[8], ga[2], gb[2];
                    { CONV_PICK(ja, min(bid, total - 1)) conv_load(ja, va, ga, kg, nq, zf); }
                    for (int t = bid; t < total; t += 2 * G) {
                        { CONV_PICK(jb, min(t + G, total - 1)) conv_load(jb, vb, gb, kg, nq, zf); }
                        conv_store(ja, va, ga, kg, nq);
                        { CONV_PICK(ja, min(t + 2 * G, total - 1)) conv_load(ja, va, ga, kg, nq, zf); }
                        if (t + G < total) conv_store(jb, vb, gb, kg, nq);
                    }
#undef CONV_PICK
                }
}

__global__ void __launch_bounds__(NTHREADS, 2) fwd(Args a_unused) {
    extern __shared__ __attribute__((aligned(16))) unsigned char lds_raw[];
    LAS unsigned char* lds = (LAS unsigned char*)lds_raw;
    const int bid0 = blockIdx.x, G0 = gridDim.x;
    volatile LAS unsigned* misc = (volatile LAS unsigned*)(lds + STAGE_LDS);
    if (threadIdx.x < 4) misc[threadIdx.x] = 0u;
    __syncthreads();
    const int wave_s = __builtin_amdgcn_readfirstlane(threadIdx.x >> 6);
    int lo, hi;
    XcdBarrier bar;
    {
        const CAS char* kp = (const CAS char*)__builtin_amdgcn_kernarg_segment_ptr();
        lo = *(const CAS int*)(kp + 168); hi = *(const CAS int*)(kp + 172);
        unsigned* bw = (unsigned*)(*(unsigned char* const CAS*)(kp + 160) + WS_CTL);
        bar.bar = bw; bar.x = 0; bar.st = misc;
        if (hi - lo > 1) bar = xcd_barrier_post(bw, misc);
    }
    int pid = 0, sidx = 0;
#define IN_PHASE (pid >= lo && pid < hi)
#define END_PHASE do { if (pid >= lo && pid + 1 < hi) for (int rb_ = 0; rb_ < REP_BAR; ++rb_) xcd_barrier(bar); ++pid; } while (0)
#define PV int bid = bid0, G = G0; asm volatile("" : "+s"(bid), "+s"(G)); const int W = G * NWAVES, GT = G * NTHREADS; (void)W; (void)GT; int lane_o; asm volatile("v_mbcnt_lo_u32_b32 %0, -1, 0\n\tv_mbcnt_hi_u32_b32 %0, -1, %0" : "=v"(lane_o)); const int lane = lane_o, wave = wave_s, tid = wave * 64 + lane, gw = bid * NWAVES + wave, gtid = bid * NTHREADS + tid; \
    (void)lane; (void)gw; (void)gtid; (void)wave; \
    const CAS char* kp = (const CAS char*)__builtin_amdgcn_kernarg_segment_ptr(); asm volatile("" : "+s"(kp)); \
    unsigned char* const ws = *(unsigned char* const CAS*)(kp + 160); float* const X = *(float* const CAS*)(kp + 152); (void)ws; (void)X;

    for (int rall_ = 0; rall_ < REP_ALL; ++rall_) {
    if (rall_ > 0) { xcd_barrier(bar); pid = 0; sidx = 0; }
    for (int f = 0; f < 4; ++f) {
        const int L = f >> 1; const bool first = (f & 1) == 0;
        if (first) {
            if (IN_PHASE) for (int rep_ = 0; rep_ < REP_CONV; ++rep_) { PV
#ifdef PROBE_STREAM
                if (L == 0) {
                    f32x4 acc4 = {0.f, 0.f, 0.f, 0.f};
                    for (int w_ = 0; w_ < 4; ++w_) {
                        const f32x4* p4 = (const f32x4*)(w_ == 0 ? INP(I_F1GU) : w_ == 1 ? INP(I_F2GU) : w_ == 2 ? INP(I_F1DN) : INP(I_F2DN));
                        const int n4 = (w_ < 2 ? 2 * D * NGU : 2 * FF * D) / 4;
                        for (int e = gtid; e < n4; e += 8 * GT) {
                            f32x4 t_[8];
#pragma unroll
                            for (int u = 0; u < 8; ++u) t_[u] = e + u * GT < n4 ? p4[e + u * GT] : acc4;
#pragma unroll
                            for (int u = 0; u < 8; ++u) acc4 += t_[u];
                        }
                    }
                    if (acc4[0] + acc4[1] + acc4[2] + acc4[3] == 1.2345e33f) P_COS[gtid] = 1.f;
                }
#endif
                if (L == 0) {
                    const int* pos = (const int*)INP(I_POS); float* cs = P_COS; float* sn = P_SIN;
                    for (int e = gtid; e < S * 64; e += GT) {
                        const int t = e >> 6, i = e & 63;
                        const float inv = exp2f(-(float)i * (13.287712379549449f / 64.0f));
                        const float ang = (float)pos[t] * inv;
                        double rev = (double)ang * 0.15915494309189535; rev -= __builtin_rint(rev);
                        const float rf = (float)rev;
                        cs[e] = __builtin_amdgcn_cosf(rf); sn[e] = __builtin_amdgcn_sinf(rf);
                    }
                    xcopy_rows(INP(I_X), P_H, (FP8_MASK & 1) ? P_H8 : nullptr, P_SS(0), gw, W, lane);
#if !MEMKV_IN_PROJ
                    if (bid & 1) for (int unit = bid; unit < 256; unit += G) memkv_unit(unit, INP(I_MEM), INP(I_MEMN), INP(I_WMKV), P_MEMK, P_MEMVT, (LAS float*)lds, tid);
#endif
                }
                conv_layer(kp, ws, L, bid, G, lane, wave);
#if !MEMKV_IN_PROJ
                if (L == 0 && !(bid & 1)) for (int unit = bid; unit < 256; unit += G) memkv_unit(unit, INP(I_MEM), INP(I_MEMN), INP(I_WMKV), P_MEMK, P_MEMVT, (LAS float*)lds, tid);
#endif
#ifdef PROBE_CONV2
                conv_layer(kp, ws, L, bid, G, lane, wave);
#endif
            }
            END_PHASE;
        }
        if (f == 2) {
            if (IN_PHASE) for (int rep_ = 0; rep_ < REP_PROJB; ++rep_) { PV
                pg8::Gemm g{P_H, P_WKV, S, KVW, D}; pg8::StaticOrder so; so.init(S, KVW, G, bid);
                RS_PREPASS(so, P_SS(sidx))
                EpiProj<2> E{P_Q, P_K, P_V, P_QI, P_KI, P_QM, P_WI, P_COS, P_SIN, INP(I_IKN), P_SS(sidx), RSL, rowbase};
                pg8::gemm_phase<EpiProj<2>, pg8::StaticOrder, false>(lds, g, so, E, nullptr, wave);
            }
            END_PHASE;
            if (IN_PHASE) for (int rep_ = 0; rep_ < REP_KVPOST; ++rep_) { PV for (int unit = bid; unit < 256; unit += G) kvpost_unit(unit, P_K, P_V, P_KMEAN, P_KBLK, P_VT, lds, tid); }
            END_PHASE;
        }
        if (IN_PHASE) for (int rep_ = 0; rep_ < REP_GU; ++rep_) { PV
            pg8::StaticOrder so; so.init(S, NGU, G, bid);
            RS_PREPASS(so, P_SS(sidx))
            if ((FP8_MASK >> f) & 1) {
                pg8::Gemm g{(const bf16_t*)P_H8, P_WGU(f & 1), S, NGU, D / 2};
#if DN8_MASK != FP8_MASK
                if (!((DN8_MASK >> f) & 1)) {
                    EpiSwiglu<true, false> E{P_ACT, P_SS(sidx), RSL, rowbase};
                    pg8::gemm_phase<EpiSwiglu<true, false>, pg8::StaticOrder, false, true>(lds, g, so, E, nullptr, wave);
                } else
#endif
                {
                    EpiSwiglu<true, true> E{P_ACT, P_SS(sidx), RSL, rowbase};
                    pg8::gemm_phase<EpiSwiglu<true, true>, pg8::StaticOrder, false, true>(lds, g, so, E, nullptr, wave);
                }
            } else {
                pg8::Gemm g{P_H, P_WGU(f & 1), S, NGU, D};
                EpiSwiglu<false> E{P_ACT, P_SS(sidx), RSL, rowbase};
                pg8::gemm_phase<EpiSwiglu<false>, pg8::StaticOrder, false, false>(lds, g, so, E, nullptr, wave);
            }
        }
        END_PHASE;
        if (IN_PHASE) { PV
            pg8::StaticOrder so; so.init(S, D, G, bid);
            if ((DN8_MASK >> f) & 1) {
                pg8::Gemm g{P_ACT, P_WDN(f & 1), S, D, FF / 2};
                EpiResid<1, true> E{P_H, (f == 1 && ((FP8_MASK >> 2) & 1)) ? P_H8 : nullptr, P_SS(sidx + 1)};
                pg8::gemm_phase<EpiResid<1, true>, pg8::StaticOrder, false, true>(lds, g, so, E, nullptr, wave);
            } else {
                pg8::Gemm g{P_ACT, P_WDN(f & 1), S, D, FF};
                EpiResid<1> E{P_H, (f == 1 && ((FP8_MASK >> 2) & 1)) ? P_H8 : nullptr, P_SS(sidx + 1)};
                pg8::gemm_phase<EpiResid<1>, pg8::StaticOrder, false>(lds, g, so, E, nullptr, wave);
            }
        }
        END_PHASE; ++sidx;
        if (!first) continue;
        if (L == 0) {
            if (IN_PHASE) for (int rep_ = 0; rep_ < REP_PROJ; ++rep_) { PV
                pg8::Gemm g{P_H, P_WIN, S, NPA, D}; pg8::StaticOrder so; so.init(S, NPA, G, bid);
                RS_PREPASS(so, P_SS(sidx))
                EpiProj<0> E{P_Q, P_K, P_V, P_QI, P_KI, P_QM, P_WI, P_COS, P_SIN, INP(I_IKN), P_SS(sidx), RSL, rowbase};
                pg8::gemm_phase<EpiProj<0>, pg8::StaticOrder, false>(lds, g, so, E, nullptr, wave);
#if MEMKV_IN_PROJ
                {
                    const int extra = ((S / pg8::BM) * (NPA / pg8::BM)) % G;
                    __syncthreads();
                    if (extra == 0) { for (int unit = bid; unit < 256; unit += G) memkv_unit(unit, INP(I_MEM), INP(I_MEMN), INP(I_WMKV), P_MEMK, P_MEMVT, (LAS float*)lds, tid); }
                    else if (bid >= extra) { for (int unit = bid - extra; unit < 256; unit += G - extra) memkv_unit(unit, INP(I_MEM), INP(I_MEMN), INP(I_WMKV), P_MEMK, P_MEMVT, (LAS float*)lds, tid); }
                }
#endif
            }
            END_PHASE;
#if IDXDSA_FUSED
            if (IN_PHASE) { PV
                volatile LAS int* flags = (volatile LAS int*)(lds + STAGE_LDS + 5120);
                if (tid < 4) flags[tid] = 0;
                __syncthreads();
                for (int item = gw; item < (S / 32) * NMH; item += W) memattn_item(item, 0, P_QM, P_MEMK, P_MEMVT, P_AO, lane);
                const int kw = wave & 3, pw = bid * 4 + kw, PW = G * 4;
                if (wave < 4) {
                    idx_phase(P_QI, P_KI, P_WI, P_SEL, P_NSEL, lds, tid, bid, G, pw, PW, lds + kw * (LCAP * 24), flags + kw);
                } else {
                    int seq = 0;
                    for (int i0 = pw; i0 < (S / 4) / 2; i0 += PW)
                        for (int rep = 0; rep < 2; ++rep) {
                            const int u = rep ? (S / 4 - 1 - i0) : i0;
                            while (flags[kw] <= seq) __builtin_amdgcn_s_sleep(8);
                            __builtin_amdgcn_fence(__ATOMIC_ACQUIRE, "workgroup");
                            for (int q = 0; q < 4; ++q)
                                dsa_query2(4 * u + q, 0, NKV, P_Q, (const unsigned char*)P_K, (const unsigned char*)P_V, P_SEL, P_NSEL, P_AO, lds + 4 * (LCAP * 24) + kw * 16384, lds + STAGE_LDS + 1024 + kw * 1024, lane);
                            ++seq;
                        }
                }
            }
            END_PHASE;
#else
            if (IN_PHASE) for (int rep_ = 0; rep_ < REP_IDX; ++rep_) { PV idx_phase(P_QI, P_KI, P_WI, P_SEL, P_NSEL, lds, tid, bid, G); }
#ifdef PROBE_IDX_MODE
            if (IN_PHASE) { PV idx_phase<PROBE_IDX_MODE>(P_QI, P_KI, P_WI, (unsigned short*)P_ACT, (int*)(P_ACT + (size_t)S * TOPK), lds, tid, bid, G); }
#endif
            END_PHASE;
            if (IN_PHASE) for (int rep_ = 0; rep_ < REP_DSA; ++rep_) { PV
                if (bid & 1) for (int item = gw; item < (S / 32) * NMH; item += W) memattn_item(item, 0, P_QM, P_MEMK, P_MEMVT, P_AO, lane);
#if DSA_MFMA == 2
                dsa_phase(P_Q, (const unsigned char*)P_K, (const unsigned char*)P_V, P_SEL, P_NSEL, P_AO, lds + wave * 16384, lds + STAGE_LDS + 1024 + wave * 1024, gw, W, lane);
#elif DSA_MFMA == 3
                if ((G & 3) == 0) {
                    const int gk = bid & 3;
                    for (int t = (bid >> 2) * NWAVES + wave; t < S; t += (G >> 2) * NWAVES)
                        dsa_kpass(t, gk, P_Q, (const unsigned char*)P_K, P_SEL, P_NSEL, (unsigned char*)P_ACT, (float*)((unsigned char*)P_ACT + (size_t)S * NKV * 768), lds + STAGE_LDS + 1024 + wave * 1024, lane);
                } else {
                    for (int t = gw; t < S; t += W) for (int gk = 0; gk < NKV; ++gk)
                        dsa_kpass(t, gk, P_Q, (const unsigned char*)P_K, P_SEL, P_NSEL, (unsigned char*)P_ACT, (float*)((unsigned char*)P_ACT + (size_t)S * NKV * 768), lds + STAGE_LDS + 1024 + wave * 1024, lane);
                }
                if (!(bid & 1)) for (int item = gw; item < (S / 32) * NMH; item += W) memattn_item(item, 0, P_QM, P_MEMK, P_MEMVT, P_AO, lane);
#elif DSA_MFMA == 1
                for (int t = gw; t < S; t += W) dsa_query2(t, 0, NKV, P_Q, (const unsigned char*)P_K, (const unsigned char*)P_V, P_SEL, P_NSEL, P_AO, lds + wave * 16384, lds + STAGE_LDS + 1024 + wave * 1024, lane);
                if (!(bid & 1)) for (int item = gw; item < (S / 32) * NMH; item += W) memattn_item(item, 0, P_QM, P_MEMK, P_MEMVT, P_AO, lane);
#else
                for (int t = gw; t < S; t += W) dsa_query(t, 0, NKV, P_Q, (const unsigned char*)P_K, (const unsigned char*)P_V, P_SEL, P_NSEL, P_AO, lds + wave * 5120, lane);
#endif
            }
            END_PHASE;
#if DSA_MFMA == 3
            if (IN_PHASE) { PV
                if ((G & 3) == 0) {
                    const int gk = bid & 3;
                    for (int t = (bid >> 2) * NWAVES + wave; t < S; t += (G >> 2) * NWAVES)
                        dsa_vpass(t, gk, (const unsigned char*)P_V, P_SEL, (const unsigned char*)P_ACT, (const float*)((unsigned char*)P_ACT + (size_t)S * NKV * 768), P_AO, lds + wave * 16384, lds + STAGE_LDS + 1024 + wave * 1024, lane);
                } else {
                    for (int t = gw; t < S; t += W) for (int gk = 0; gk < NKV; ++gk)
                        dsa_vpass(t, gk, (const unsigned char*)P_V, P_SEL, (const unsigned char*)P_ACT, (const float*)((unsigned char*)P_ACT + (size_t)S * NKV * 768), P_AO, lds + wave * 16384, lds + STAGE_LDS + 1024 + wave * 1024, lane);
                }
            }
            END_PHASE;
#endif
#endif
        } else {
            if (IN_PHASE) for (int rep_ = 0; rep_ < REP_PROJB; ++rep_) { PV
                pg8::Gemm g{P_H, P_WIN, S, B_IN, D}; pg8::StaticOrder so; so.init(S, B_IN, G, bid);
                RS_PREPASS(so, P_SS(sidx))
                EpiProj<1> E{P_Q, P_K, P_V, P_QI, P_KI, P_QM, P_WI, P_COS, P_SIN, INP(I_IKN), P_SS(sidx), RSL, rowbase};
                pg8::gemm_phase<EpiProj<1>, pg8::StaticOrder, false>(lds, g, so, E, nullptr, wave);
            }
            END_PHASE;
            if (IN_PHASE) for (int rep_ = 0; rep_ < REP_M1; ++rep_) { PV for (int unit = bid; unit < 256; unit += G) moba_gate_unit(unit, P_Q, P_KMEAN, P_ITEMS, P_NITEMS, P_IB, lds, tid); }
            END_PHASE;
            if (IN_PHASE) for (int rep_ = 0; rep_ < REP_M2; ++rep_) { PV
                if (bid & 1) for (int item = gw; item < (S / 32) * NMH; item += W) memattn_item(item, 1, P_QM, P_MEMK, P_MEMVT, P_AOB, lane);
                moba_phase_lds(P_Q, P_KBLK, P_VT, P_ITEMS, P_IB, P_PO, P_PML, lds, tid, bid, G);
                if (!(bid & 1)) for (int item = gw; item < (S / 32) * NMH; item += W) memattn_item(item, 1, P_QM, P_MEMK, P_MEMVT, P_AOB, lane);
            }
            END_PHASE;
            if (IN_PHASE) for (int rep_ = 0; rep_ < REP_MERGE; ++rep_) { PV moba_merge(P_PO, P_PML, P_AOB, gtid, GT); }
            END_PHASE;
        }
        if (IN_PHASE) { PV
            pg8::Gemm g{L == 0 ? P_AO : P_AOB, P_WOUT, S, D, D}; pg8::StaticOrder so; so.init(S, D, G, bid);
            EpiResid<0> E{P_H, ((FP8_MASK >> (2 * L + 1)) & 1) ? P_H8 : nullptr, P_SS(sidx + 1)};
            pg8::gemm_phase<EpiResid<0>, pg8::StaticOrder, false>(lds, g, so, E, nullptr, wave);
        }
        END_PHASE; ++sidx;
    }
    if (rall_ + 1 < REP_ALL) {   } else
    if (IN_PHASE) { PV final_norm_rows(P_H, X, INP(I_FINN), P_SS(sidx), gw, W, lane); }
    END_PHASE;
    }
#undef IN_PHASE
#undef END_PHASE
}
constexpr int N_PHASES = 7 + 2 + 10 + 2 + 1 - (IDXDSA_FUSED ? 1 : 0) + ((!IDXDSA_FUSED && DSA_MFMA == 3) ? 1 : 0);

extern "C" void kernel_launch(void* const* d_in, const int* in_sizes, int n_in, void* d_out, int out_size, void* d_ws, size_t ws_size, hipStream_t stream) {
    static int grid = 0;
    if (grid == 0) {
        if (n_in != 19 || out_size != S * D || ws_size < WS_END) { fprintf(stderr, "kernel_launch: unexpected shapes (n_in %d out %d ws %zu need %zu)\n", n_in, out_size, ws_size, (size_t)WS_END); grid = -1; return; }
        int dev = 0, cus = 0, per_cu = 0;
        if (hipGetDevice(&dev) != hipSuccess || hipDeviceGetAttribute(&cus, hipDeviceAttributeMultiprocessorCount, dev) != hipSuccess) { grid = -1; return; }
        if (hipFuncSetAttribute((const void*)fwd, hipFuncAttributeMaxDynamicSharedMemorySize, LDS_BYTES) != hipSuccess) { fprintf(stderr, "kernel_launch: hipFuncSetAttribute failed\n"); grid = -1; return; }
        if (hipOccupancyMaxActiveBlocksPerMultiprocessor(&per_cu, (const void*)fwd, NTHREADS, LDS_BYTES) != hipSuccess || per_cu < 1) { fprintf(stderr, "kernel_launch: occupancy query says %d\n", per_cu); (void)hipGetLastError(); grid = -1; return; }
        grid = cus;
    }
    if (grid < 0) return;
    (void)hipMemsetAsync((char*)d_ws + WS_CTL, 0, ZERO_BYTES, stream);
    Args a{};
    for (int i = 0; i < 19; ++i) a.in[i] = (const float*)d_in[i];
    a.out = (float*)d_out; a.ws = (unsigned char*)d_ws;
#if MK_ONE_LAUNCH
    a.ph_lo = 0; a.ph_hi = N_PHASES;
    hipLaunchKernelGGL(fwd, dim3(grid), dim3(NTHREADS), LDS_BYTES, stream, a);
#else
    for (int p = 0; p < N_PHASES; ++p) { a.ph_lo = p; a.ph_hi = p + 1; hipLaunchKernelGGL(fwd, dim3(grid), dim3(NTHREADS), LDS_BYTES, stream, a); }
#endif
}
```
